# Optimizing an MI355X kernel written in HIP

```python
import math
import jax, jax.numpy as jnp
from jax import lax
import numpy as np

D_MODEL = 1024
BATCH = 16
SEQ = 256
DEPTH = 2
DEC_BATCH = 2
DEC_SEQ = 2048
PAST_LEN = 256

GRID_W = 64
N_AB = (DEPTH + 1) // 2
N_NA = DEPTH // 2
D_FF = 2816
N_ADA = 9
EPS = 1e-6
CHUNK = 64
QBLK = 128
H_A = 4
DQK_A = 64
DV_A = 128
H_B = 4
DK_B = 128
DV_B = 128
CONV_K = 5
H_C = 16
DH_C = 64
WIN_R = 8
WIN_C = 16

AB_SIZES = (H_A * DQK_A, H_A * DQK_A, H_A * DV_A, H_A * DV_A, 2 * H_A, 2 * H_A,
            H_B * DK_B, H_B * DK_B, H_B * DV_B, H_B * DV_B, 2 * H_B, 2 * H_B)
AB_IN = sum(AB_SIZES)
AB_OUT = H_A * DV_A + H_B * DV_B
QKV_B = 2 * H_B * DK_B + H_B * DV_B
NA_W = H_C * DH_C

kernel_name = 'hybrid_mlstm_deltanet_natten_prefix_dit_step'


def rmsnorm(x, g):
    xf = x.astype(jnp.float32)
    y = xf * lax.rsqrt(jnp.mean(xf * xf, axis=-1, keepdims=True) + EPS)
    return (y * g.astype(jnp.float32)).astype(x.dtype)


def head_rms(x):
    return x * lax.rsqrt(jnp.mean(x * x, axis=-1, keepdims=True) + EPS)


def l2norm(x):
    return x * lax.rsqrt(jnp.sum(x * x, axis=-1, keepdims=True) + EPS)


def modulate(x, g, shift, scale):
    return rmsnorm(x, g) * (1 + scale) + shift


def swiglu(h, wg, wu, wd):
    return (jax.nn.silu(h @ wg) * (h @ wu)) @ wd


def split_heads(a, n_heads):
    b, t, _ = a.shape
    return a.reshape(b, t, n_heads, -1).transpose(0, 2, 1, 3)


def merge_heads(a):
    b, h, t, d = a.shape
    return a.transpose(0, 2, 1, 3).reshape(b, t, h * d)


def dir_gates(a):
    b, t, _ = a.shape
    return a.reshape(b, t, 2, -1).transpose(0, 2, 3, 1).astype(jnp.float32)


def flip_t(a):
    return jnp.flip(a, axis=2)


def to_chunks(a):
    nc = a.shape[2] // CHUNK
    return jnp.moveaxis(a.reshape(a.shape[:2] + (nc, CHUNK) + a.shape[3:]), 2, 0)


def from_chunks(a):
    a = jnp.moveaxis(a, 0, 2)
    return a.reshape(a.shape[:2] + (a.shape[2] * a.shape[3],) + a.shape[4:])


def short_conv(x, w):
    ch = x.shape[-1]
    return lax.conv_general_dilated(x, w[:, None, :].astype(x.dtype), window_strides=(1,),
                                    padding=[(CONV_K // 2, CONV_K // 2)],
                                    dimension_numbers=('NWC', 'WIO', 'NWC'),
                                    feature_group_count=ch)


def mlstm_chunked(q, k, v, logi, logf, c0, n0, m0):
    tri = jnp.tril(jnp.ones((CHUNK, CHUNK), bool))

    def step(carry, inp):
        cm, nv, m = carry
        qc, kc, vc, ic, fc = inp
        b = jnp.cumsum(fc, axis=-1)
        dmat = jnp.where(tri, b[..., :, None] - b[..., None, :] + ic[..., None, :], -jnp.inf)
        m_inter = b + m[..., None]
        m_t = jnp.maximum(m_inter, jnp.max(dmat, axis=-1))
        a_inter = jnp.exp(m_inter - m_t)
        sw = jnp.einsum('bhtd,bhsd->bhts', qc, kc) * jnp.exp(dmat - m_t[..., None])
        num = (jnp.einsum('bhts,bhsv->bhtv', sw, vc)
               + a_inter[..., None] * jnp.einsum('bhtd,bhdv->bhtv', qc, cm))
        den = jnp.sum(sw, axis=-1) + a_inter * jnp.einsum('bhtd,bhd->bht', qc, nv)
        h = num / jnp.maximum(jnp.abs(den), jnp.exp(-m_t))[..., None]
        b_last = b[..., -1]
        gs = b_last[..., None] - b + ic
        m_new = jnp.maximum(b_last + m, jnp.max(gs, axis=-1))
        carry_decay = jnp.exp(b_last + m - m_new)
        ws = jnp.exp(gs - m_new[..., None])
        cm = carry_decay[..., None, None] * cm + jnp.einsum('bhs,bhsd,bhsv->bhdv', ws, kc, vc)
        nv = carry_decay[..., None] * nv + jnp.einsum('bhs,bhsd->bhd', ws, kc)
        return (cm, nv, m_new), h

    (cm, nv, m), h = lax.scan(step, (c0, n0, m0), tuple(to_chunks(a) for a in (q, k, v, logi, logf)))
    return from_chunks(h), (cm, nv, m)


def gated_delta_chunked(q, k, v, g, beta, s0):
    qc, kc, vc = to_chunks(q), to_chunks(k), to_chunks(v)
    gc = jnp.cumsum(to_chunks(g), axis=-1)
    bc = to_chunks(beta)
    tri = jnp.tril(jnp.ones((CHUNK, CHUNK), bool))
    strict = jnp.tril(jnp.ones((CHUNK, CHUNK), bool), -1)
    decay = jnp.exp(jnp.where(tri, gc[..., :, None] - gc[..., None, :], -jnp.inf))
    kb = kc * bc[..., None]
    mlow = jnp.where(strict, jnp.einsum('nbhtd,nbhsd->nbhts', kb, kc) * decay, 0.0)
    amat = mlow + jnp.eye(CHUNK, dtype=mlow.dtype)
    u = lax.linalg.triangular_solve(amat, vc * bc[..., None], left_side=True, lower=True,
                                    unit_diagonal=True)
    w = lax.linalg.triangular_solve(amat, kb * jnp.exp(gc)[..., None], left_side=True, lower=True,
                                    unit_diagonal=True)
    qk = jnp.where(tri, jnp.einsum('nbhtd,nbhsd->nbhts', qc, kc) * decay, 0.0)
    qg = qc * jnp.exp(gc)[..., None]
    kd = kc * jnp.exp(gc[..., -1:] - gc)[..., None]
    gl = jnp.exp(gc[..., -1])

    def step(s, inp):
        u_i, w_i, qk_i, qg_i, kd_i, gl_i = inp
        v_new = u_i - jnp.einsum('bhtd,bhdv->bhtv', w_i, s)
        o = jnp.einsum('bhtd,bhdv->bhtv', qg_i, s) + jnp.einsum('bhts,bhsv->bhtv', qk_i, v_new)
        s = s * gl_i[..., None, None] + jnp.einsum('bhsd,bhsv->bhdv', kd_i, v_new)
        return s, o

    s, o = lax.scan(step, s0, (u, w, qk, qg, kd, gl))
    return from_chunks(o), s


def ab_mixer(h, w_in, w_out, b_i, b_f, g_m, conv_w, a_log, dt_bias, g_d, c0, n0, m0, s0):
    f32 = jnp.float32
    idx = np.cumsum(AB_SIZES)[:-1].tolist()
    (q_m, k_m, v_m, o_m, i_pre, f_pre,
     q_d, k_d, v_d, z_d, b_pre, a_pre) = jnp.split(h @ w_in, idx, axis=-1)
    qm = split_heads(q_m, H_A).astype(f32) * DQK_A ** -0.5
    km = split_heads(k_m, H_A).astype(f32)
    vm = split_heads(v_m, H_A).astype(f32)
    logi = dir_gates(i_pre) + b_i[None, :, :, None]
    logf = jax.nn.log_sigmoid(dir_gates(f_pre) + b_f[None, :, :, None])
    c0, n0, m0, s0 = c0.astype(f32), n0.astype(f32), m0.astype(f32), s0.astype(f32)
    hf, (cf, nf, mf) = mlstm_chunked(qm, km, vm, logi[:, 0], logf[:, 0], c0[:, 0], n0[:, 0], m0[:, 0])
    hb, (cb, nb, mb) = mlstm_chunked(flip_t(qm), flip_t(km), flip_t(vm), flip_t(logi[:, 1]),
                                     flip_t(logf[:, 1]), c0[:, 1], n0[:, 1], m0[:, 1])
    hm = merge_heads(head_rms(hf + flip_t(hb))) * g_m * jax.nn.sigmoid(o_m.astype(f32))
    qkv = jax.nn.silu(short_conv(jnp.concatenate([q_d, k_d, v_d], axis=-1), conv_w))
    q_d, k_d, v_d = jnp.split(qkv, [H_B * DK_B, 2 * H_B * DK_B], axis=-1)
    qd = l2norm(split_heads(q_d, H_B).astype(f32)) * DK_B ** -0.5
    kd = l2norm(split_heads(k_d, H_B).astype(f32))
    vd = split_heads(v_d, H_B).astype(f32)
    beta = jax.nn.sigmoid(dir_gates(b_pre))
    g = -jnp.exp(a_log.astype(f32))[None, :, :, None] * jax.nn.softplus(dir_gates(a_pre) + dt_bias[None, :, :, None])
    of, sf = gated_delta_chunked(qd, kd, vd, g[:, 0], beta[:, 0], s0[:, 0])
    ob, sb = gated_delta_chunked(flip_t(qd), flip_t(kd), flip_t(vd), flip_t(g[:, 1]),
                                 flip_t(beta[:, 1]), s0[:, 1])
    od = merge_heads(head_rms(of + flip_t(ob)) * g_d) * jax.nn.silu(z_d.astype(f32))
    out = jnp.concatenate([hm, od], axis=-1).astype(h.dtype) @ w_out
    return out, (jnp.stack([cf, cb], axis=1), jnp.stack([nf, nb], axis=1),
                 jnp.stack([mf, mb], axis=1), jnp.stack([sf, sb], axis=1))


def na_project(h, w_in):
    q, k, v = jnp.split(h @ w_in, 3, axis=-1)
    return split_heads(q, H_C), split_heads(k, H_C), split_heads(v, H_C)


def context_attention(q, k, v):
    b, hh, t, d = q.shape
    qb = jnp.moveaxis(q.reshape(b, hh, t // QBLK, QBLK, d), 2, 0)

    def block(qi):
        s = jnp.einsum('bhqd,bhkd->bhqk', qi, k).astype(jnp.float32) * DH_C ** -0.5
        p = jax.nn.softmax(s, axis=-1).astype(v.dtype)
        return jnp.einsum('bhqk,bhkd->bhqd', p, v)

    o = lax.map(block, qb)
    return jnp.moveaxis(o, 0, 2).reshape(b, hh, t, d)


def neighbourhood_attention(q, k, v, kc, vc, rel_bias):
    b, hh, n, d = q.shape
    rows = n // GRID_W
    wr = min(WIN_R, rows)
    r = np.arange(rows)
    krow = np.clip(r - wr // 2, 0, rows - wr)[:, None] + np.arange(wr)[None, :]
    col = np.arange(GRID_W)
    cs = np.clip(col - WIN_C // 2, 0, GRID_W - WIN_C)
    valid = (col[None, :] >= cs[:, None]) & (col[None, :] < cs[:, None] + WIN_C)
    ridx = krow - r[:, None] + WIN_R - 1
    cidx = np.clip(col[None, :] - col[:, None], -(WIN_C - 1), WIN_C - 1) + WIN_C - 1
    bias = rel_bias[:, ridx[:, None, :, None], cidx[None, :, None, :]].astype(jnp.float32)
    bias = jnp.where(valid[None, None, :, None, :], bias, -jnp.inf)
    scale = DH_C ** -0.5
    qg = q.reshape(b, hh, rows, GRID_W, d)
    kband = k.reshape(b, hh, rows, GRID_W, d)[:, :, krow]
    vband = v.reshape(b, hh, rows, GRID_W, d)[:, :, krow]
    s_loc = jnp.einsum('bhrqd,bhrwkd->bhrqwk', qg, kband).astype(jnp.float32) * scale + bias[None]
    s_ctx = jnp.einsum('bhrqd,bhpd->bhrqp', qg, kc).astype(jnp.float32) * scale
    nloc = wr * GRID_W
    p = jax.nn.softmax(jnp.concatenate([s_loc.reshape(b, hh, rows, GRID_W, nloc), s_ctx], axis=-1), axis=-1)
    p_loc = p[..., :nloc].reshape(b, hh, rows, GRID_W, wr, GRID_W).astype(v.dtype)
    p_ctx = p[..., nloc:].astype(vc.dtype)
    o = (jnp.einsum('bhrqwk,bhrwkd->bhrqd', p_loc, vband)
         + jnp.einsum('bhrqp,bhpd->bhrqd', p_ctx, vc))
    return o.reshape(b, hh, n, d)


def setup_inputs(seed: int = 0) -> dict:
    key = jax.random.key(seed)
    ks = iter(jax.random.split(key, 40))

    def nrm(shape, s):
        return jax.random.normal(next(ks), shape, jnp.float32) * s

    inp = {}
    inp['x_prompt'] = nrm((BATCH, SEQ, D_MODEL), 1.0)
    inp['x_sample'] = nrm((DEC_BATCH, DEC_SEQ, D_MODEL), 1.0)
    inp['c'] = nrm((DEC_BATCH, D_MODEL), 1.0)
    inp['state_mlstm_C'] = nrm((DEC_BATCH, N_AB, 2, H_A, DQK_A, DV_A), 0.5)
    inp['state_mlstm_n'] = nrm((DEC_BATCH, N_AB, 2, H_A, DQK_A), 0.5)
    inp['state_mlstm_m'] = nrm((DEC_BATCH, N_AB, 2, H_A), 0.5)
    inp['state_delta_S'] = nrm((DEC_BATCH, N_AB, 2, H_B, DK_B, DV_B), 0.1)
    inp['cache_na_k'] = nrm((DEC_BATCH, N_NA, H_C, PAST_LEN, DH_C), 1.0)
    inp['cache_na_v'] = nrm((DEC_BATCH, N_NA, H_C, PAST_LEN, DH_C), 1.0)
    inp['c_ctx'] = nrm((D_MODEL,), 1.0)
    inp['ada_w'] = nrm((DEPTH, D_MODEL, N_ADA * D_MODEL), 0.5 * D_MODEL ** -0.5)
    inp['ada_b'] = nrm((DEPTH, N_ADA * D_MODEL), 0.02)
    inp['norm_g'] = 1.0 + nrm((DEPTH, 3, D_MODEL), 0.02)
    inp['ffn_wg'] = nrm((DEPTH, 2, D_MODEL, D_FF), D_MODEL ** -0.5)
    inp['ffn_wu'] = nrm((DEPTH, 2, D_MODEL, D_FF), D_MODEL ** -0.5)
    inp['ffn_wd'] = nrm((DEPTH, 2, D_FF, D_MODEL), D_FF ** -0.5)
    inp['ab_w_in'] = nrm((N_AB, D_MODEL, AB_IN), D_MODEL ** -0.5)
    inp['ab_w_out'] = nrm((N_AB, AB_OUT, D_MODEL), AB_OUT ** -0.5)
    inp['mlstm_b_i'] = nrm((N_AB, 2, H_A), 0.1)
    inp['mlstm_b_f'] = 3.0 + nrm((N_AB, 2, H_A), 0.5)
    inp['mlstm_norm_g'] = 1.0 + nrm((N_AB, H_A * DV_A), 0.02)
    inp['delta_conv_w'] = nrm((N_AB, CONV_K, QKV_B), CONV_K ** -0.5)
    inp['delta_a_log'] = jnp.log(jax.random.uniform(next(ks), (N_AB, 2, H_B), jnp.float32, minval=1.0, maxval=16.0))
    dt = jnp.exp(jax.random.uniform(next(ks), (N_AB, 2, H_B), jnp.float32,
                                    minval=math.log(1e-3), maxval=math.log(1e-1)))
    inp['delta_dt_bias'] = dt + jnp.log(-jnp.expm1(-dt))
    inp['delta_norm_g'] = 1.0 + nrm((N_AB, DV_B), 0.02)
    inp['na_w_in'] = nrm((N_NA, D_MODEL, 3 * NA_W), D_MODEL ** -0.5)
    inp['na_w_out'] = nrm((N_NA, NA_W, D_MODEL), NA_W ** -0.5)
    inp['na_rel_bias'] = nrm((N_NA, H_C, 2 * WIN_R - 1, 2 * WIN_C - 1), 0.1)
    inp['final_norm_g'] = 1.0 + nrm((D_MODEL,), 0.02)
    return inp


def reference(x_prompt, x_sample, c, state_mlstm_C, state_mlstm_n, state_mlstm_m, state_delta_S,
              cache_na_k, cache_na_v, c_ctx, ada_w, ada_b, norm_g, ffn_wg, ffn_wu, ffn_wd,
              ab_w_in, ab_w_out, mlstm_b_i, mlstm_b_f, mlstm_norm_g, delta_conv_w, delta_a_log,
              delta_dt_bias, delta_norm_g, na_w_in, na_w_out, na_rel_bias, final_norm_g):
    xp, xs = x_prompt, x_sample
    bp = xp.shape[0]
    f32 = jnp.float32
    new_c, new_n, new_m, new_s, new_k, new_v = [], [], [], [], [], []
    for l in range(DEPTH):
        mp = jnp.split((jax.nn.silu(c_ctx) @ ada_w[l] + ada_b[l])[None, None, :], N_ADA, axis=-1)
        ms = jnp.split((jax.nn.silu(c) @ ada_w[l] + ada_b[l])[:, None, :], N_ADA, axis=-1)
        xp = xp + 0.5 * mp[2] * swiglu(modulate(xp, norm_g[l, 0], mp[0], mp[1]), ffn_wg[l, 0], ffn_wu[l, 0], ffn_wd[l, 0])
        xs = xs + 0.5 * ms[2] * swiglu(modulate(xs, norm_g[l, 0], ms[0], ms[1]), ffn_wg[l, 0], ffn_wu[l, 0], ffn_wd[l, 0])
        hp = modulate(xp, norm_g[l, 1], mp[3], mp[4])
        hs = modulate(xs, norm_g[l, 1], ms[3], ms[4])
        a = l // 2
        if l % 2 == 0:
            prm = (ab_w_in[a], ab_w_out[a], mlstm_b_i[a], mlstm_b_f[a], mlstm_norm_g[a], delta_conv_w[a],
                   delta_a_log[a], delta_dt_bias[a], delta_norm_g[a])
            op, (cn, nn_, mn, sn) = ab_mixer(
                hp, *prm,
                jnp.zeros((bp, 2, H_A, DQK_A, DV_A), f32), jnp.zeros((bp, 2, H_A, DQK_A), f32),
                jnp.zeros((bp, 2, H_A), f32), jnp.zeros((bp, 2, H_B, DK_B, DV_B), f32))
            os_, _ = ab_mixer(hs, *prm, state_mlstm_C[:, a], state_mlstm_n[:, a],
                              state_mlstm_m[:, a], state_delta_S[:, a])
            new_c.append(cn)
            new_n.append(nn_)
            new_m.append(mn)
            new_s.append(sn)
        else:
            qp, kp, vp = na_project(hp, na_w_in[a])
            op = merge_heads(context_attention(qp, kp, vp)) @ na_w_out[a]
            qs, ks_, vs = na_project(hs, na_w_in[a])
            os_ = merge_heads(neighbourhood_attention(qs, ks_, vs, cache_na_k[:, a], cache_na_v[:, a],
                                                      na_rel_bias[a])) @ na_w_out[a]
            new_k.append(kp)
            new_v.append(vp)
        xp = xp + mp[5] * op
        xs = xs + ms[5] * os_
        xp = xp + 0.5 * mp[8] * swiglu(modulate(xp, norm_g[l, 2], mp[6], mp[7]), ffn_wg[l, 1], ffn_wu[l, 1], ffn_wd[l, 1])
        xs = xs + 0.5 * ms[8] * swiglu(modulate(xs, norm_g[l, 2], ms[6], ms[7]), ffn_wg[l, 1], ffn_wu[l, 1], ffn_wd[l, 1])
    y_prompt = rmsnorm(xp, final_norm_g)
    y_sample = rmsnorm(xs, final_norm_g)
    return (y_prompt, y_sample, jnp.stack(new_c, axis=1), jnp.stack(new_n, axis=1),
            jnp.stack(new_m, axis=1), jnp.stack(new_s, axis=1), jnp.stack(new_k, axis=1),
            jnp.stack(new_v, axis=1))
```

```cpp
#include <hip/hip_runtime.h>
#include <hip/hip_cooperative_groups.h>
#include <cstdio>
#include <cstdint>
namespace cg = cooperative_groups;

#ifndef PROBE
#define PROBE 0
#endif
#ifndef N_LAUNCH_MODE
#define N_LAUNCH_MODE 1
#endif

typedef unsigned short bf16;
typedef short bf16x8 __attribute__((ext_vector_type(8)));
typedef float f32x4 __attribute__((ext_vector_type(4)));
typedef unsigned u32x4 __attribute__((ext_vector_type(4)));
typedef unsigned u32x2 __attribute__((ext_vector_type(2)));

#define NT 512
#define NWV 8
#define LDS_BYTES 147456

constexpr size_t WS_X = 0;
constexpr size_t WS_HN = WS_X + 33554432;
constexpr size_t WS_MOD = WS_HN + 16777216;
constexpr size_t WS_CK = WS_MOD + 221184;
constexpr size_t WS_CVT = WS_CK + 1048576;
constexpr size_t WS_W = WS_CVT + 1048576;
constexpr size_t W_GU0 = 0, W_D0 = 11534336, W_IN = 17301504, W_GU1 = 25165824, W_D1 = 36700160, W_OUT = 42467328, W_TOTAL = 44564480;
constexpr size_t W_CST = 0;
constexpr size_t WS_R = WS_W + W_TOTAL;
constexpr size_t R_ACT = 0;
constexpr size_t R_PROJ = 0, R_GATES = 59244544, R_HM = 60293120, R_HD = 77070336, R_D1 = 93847552, R_KV = 169607168, R_MS = 203423744, R_END = 203440128;
constexpr size_t R_PART = 67108864;
constexpr size_t R_Q = 0, R_K = 16777216, R_VT = 33554432;
constexpr size_t WS_BAR = WS_R + R_END;
constexpr size_t WS_END = WS_BAR + 16384;
constexpr int REC = 73984;

struct P { const float* in[29]; float* out; unsigned char* ws; int ph_lo, ph_hi, tid, bid; };

constexpr size_t O_YP = 0, O_YS = 4194304, O_C = 8388608, O_N = O_C + 1048576, O_M = O_N + 8192, O_S = O_M + 128, O_K = O_S + 2097152, O_V = O_K + 4194304;

__device__ __forceinline__ unsigned pk2(float a, float b) { unsigned r; asm("s_nop 1\n\tv_cvt_pk_bf16_f32 %0, %1, %2" : "=v"(r) : "v"(a), "v"(b)); return r; }
__device__ __forceinline__ bf16 f2b(float f) { return (bf16)(pk2(f, f) & 0xffffu); }
__device__ __forceinline__ float b2f(bf16 b) { return __uint_as_float(((unsigned)b) << 16); }

__device__ __forceinline__ float silu_f(float x) { return x * __builtin_amdgcn_rcpf(1.f + __expf(-x)); }
__device__ __forceinline__ float sigm_f(float x) { return __builtin_amdgcn_rcpf(1.f + __expf(-x)); }
__device__ __forceinline__ float softplus_f(float x) { return fmaxf(x, 0.f) + __logf(1.f + __expf(-fabsf(x))); }
__device__ __forceinline__ int grp_of(int row) { return row < 4096 ? 0 : 1 + ((row - 4096) >> 11); }
__device__ __forceinline__ uint4 ld_nt16(const void* p) { const u32x4 t = __builtin_nontemporal_load((const u32x4*)p); return make_uint4(t[0], t[1], t[2], t[3]); }
__device__ __forceinline__ void lds_barrier() { asm volatile("s_waitcnt lgkmcnt(0)\n\ts_barrier" ::: "memory"); }
template <int CTRL> __device__ __forceinline__ float dppf(float x) { return __builtin_bit_cast(float, __builtin_amdgcn_update_dpp(0, __builtin_bit_cast(int, x), CTRL, 0xF, 0xF, true)); }
__device__ __forceinline__ float row16_max(float x) { x = fmaxf(x, dppf<0x128>(x)); x = fmaxf(x, dppf<0x124>(x)); x = fmaxf(x, dppf<0x122>(x)); return fmaxf(x, dppf<0x121>(x)); }
__device__ __forceinline__ float row16_sum(float x) { x += dppf<0x128>(x); x += dppf<0x124>(x); x += dppf<0x122>(x); return x + dppf<0x121>(x); }
__device__ __forceinline__ f32x4 mfma16(bf16x8 a, bf16x8 b, f32x4 c) { return __builtin_amdgcn_mfma_f32_16x16x32_bf16(a, b, c, 0, 0, 0); }

template <int M, int N, int K, class F>
__device__ __forceinline__ void mm(int tid_, const bf16* A, int lda, const bf16* B, int ldb, F&& f) {
    const int lane = tid_ & 63, wave = tid_ >> 6, r = lane & 15, q = lane >> 4;
    constexpr int TN = N / 16, NTL = (M / 16) * TN, ITERS = (NTL + NWV - 1) / NWV;
#pragma unroll
    for (int it = 0; it < ITERS; ++it) {
        const int t = wave + it * NWV;
        if (t < NTL) {
            const int tm = t / TN, tn = t % TN;
            f32x4 acc = {0.f, 0.f, 0.f, 0.f};
#pragma unroll
            for (int k = 0; k < K; k += 32) {
                bf16x8 a = *(const bf16x8*)(A + (tm * 16 + r) * lda + k + q * 8);
                bf16x8 b = *(const bf16x8*)(B + (tn * 16 + r) * ldb + k + q * 8);
                acc = mfma16(a, b, acc);
            }
#pragma unroll
            for (int e = 0; e < 4; ++e) f(it, e, tm * 16 + q * 4 + e, tn * 16 + r, acc[e]);
        }
    }
}

namespace pg8 {
#define PG8_LAS __attribute__((address_space(3)))
typedef unsigned short bf16_t;
typedef short bf16x8 __attribute__((ext_vector_type(8)));
typedef float f32x4 __attribute__((ext_vector_type(4)));
constexpr int BM = 256, BK = 64, HALF = 128, HTB = HALF * BK * 2, STAGE_BYTES = 8 * HTB, NXCD = 8, WGM = 8;
__host__ __device__ __forceinline__ int lds_byte(int r, int c) { const int st = (r >> 4) * 2 + (c >> 5), rr = r & 15, cc = c & 31, ob = rr * 64 + cc * 2; return st * 1024 + (ob ^ (((ob >> 9) & 1) << 5)); }
__host__ __device__ __forceinline__ void stage_rc(int b, int& R, int& C) { const int st = b / 1024, sb = b % 1024, swz = sb ^ (((sb >> 9) & 1) << 5); R = (st >> 1) * 16 + swz / 64; C = (st & 1) * 32 + (swz % 64) / 2; }
__host__ __device__ __forceinline__ int perm32(int rho) { const int n = rho >> 4, i = rho & 15; return 8 * (i >> 2) + 4 * n + (i & 3); }
struct Unit { int pm, pn, ko; };
struct Gemm { const bf16_t* A; const bf16_t* Bt; int ld, K; };
struct StaticOrder {
    int nM, nN, nwg, G, c;
    __device__ void init(int M, int N, int G_, int c_) { nM = M / BM; nN = N / BM; nwg = nM * nN; G = G_; c = c_; }
    __device__ bool next(int i, Unit& u) const {
        const long L = (long)i * G + c; if (L >= nwg) return false;
        int wgid = (int)L; { const int q = nwg / NXCD, r = nwg % NXCD, xcd = wgid % NXCD, off = wgid / NXCD; wgid = (xcd < r ? xcd * (q + 1) : r * (q + 1) + (xcd - r) * q) + off; }
        const int nig = WGM * nN, gid = wgid / nig, fm = gid * WGM, gsz = (nM - fm) < WGM ? (nM - fm) : WGM;
        u.pm = fm + ((wgid % nig) % gsz); u.pn = (wgid % nig) / gsz; u.ko = 0; return true;
    }
    __device__ __forceinline__ void a_ready(const Unit&) const {}
    __device__ __forceinline__ void done(const Unit&) const {}
};
struct SplitK2Order {
    int c, G, kbytes;
    __device__ bool next(int i, Unit& u) const {
        const int L = i * G + c; if (L >= 256) return false;
        const int x = L & 7, o = L >> 3; u.pm = 4 * x + (o & 3); u.pn = (o >> 2) & 3; u.ko = (o >> 4) * kbytes; return true;
    }
    __device__ __forceinline__ void a_ready(const Unit&) const {}
    __device__ __forceinline__ void done(const Unit&) const {}
};
template <class Epi, class Sched, bool ALIGN_EPI = false, bool SP2 = false>
__device__ __forceinline__ void gemm_phase(PG8_LAS unsigned char* lds, const Gemm g, const Sched& S, const Epi& E, int tid_in) {
    const int tid = tid_in, wid = __builtin_amdgcn_readfirstlane(tid >> 6), lane = tid & 63, wr = wid >> 2, wc = wid & 3, fr = lane & 15, fq = lane >> 4;
    const int K = g.ld, nt = g.K / BK;
    unsigned voffA[2], voffB[2];
#pragma unroll
    for (int i = 0; i < 2; ++i) { int R, C; stage_rc(tid * 16 + i * 8192, R, C); const int Rb = Epi::PERM ? ((R & ~31) + perm32(R & 31)) : R;
        voffA[i] = (unsigned)(R * K + C) * 2u; voffB[i] = (unsigned)(Rb * K + C) * 2u; }
    const size_t kstep = (size_t)(BK * 2);
    const size_t hstep = (size_t)HALF * K * 2;
    const size_t tstep = 2 * hstep;
    const unsigned ldsw = (unsigned)wid * 1024u;
    const int aoff = lds_byte(wr * 64 + fr, fq * 8), boff = lds_byte(wc * 32 + fr, fq * 8);
#define PG8_SA(b, h) (((b) * 2 + (h)) * HTB)
#define PG8_SB(b, h) ((4 + (b) * 2 + (h)) * HTB)
#define PG8_STAGE(bufoff, gbase, voff) do { _Pragma("unroll") for (int _i = 0; _i < 2; ++_i) \
        __builtin_amdgcn_global_load_lds((const unsigned*)((const char*)(gbase) + (voff)[_i]), (PG8_LAS unsigned*)(lds + (bufoff) + ldsw + _i * 8192), 16, 0, 0); } while (0)
#define PG8_LDA(dst, b, h) do { _Pragma("unroll") for (int m = 0; m < 4; ++m) _Pragma("unroll") for (int k = 0; k < 2; ++k) dst[m][k] = *(const PG8_LAS bf16x8*)(lds + PG8_SA(b, h) + aoff + m * 2048 + k * 1024); } while (0)
#define PG8_LDB(dst, b, h) do { _Pragma("unroll") for (int n = 0; n < 2; ++n) _Pragma("unroll") for (int k = 0; k < 2; ++k) dst[n][k] = *(const PG8_LAS bf16x8*)(lds + PG8_SB(b, h) + boff + n * 2048 + k * 1024); } while (0)
#define PG8_MMA(ai, bj, At, Bt) do { __builtin_amdgcn_s_setprio(1); _Pragma("unroll") for (int m = 0; m < 4; ++m) _Pragma("unroll") for (int n = 0; n < 2; ++n) _Pragma("unroll") for (int k = 0; k < 2; ++k) \
        acc[ai][bj][m][n] = __builtin_amdgcn_mfma_f32_16x16x32_bf16(Bt[n][k], At[m][k], acc[ai][bj][m][n], 0, 0, 0); __builtin_amdgcn_s_setprio(0); } while (0)
#define PG8_WAIT_V(n) asm volatile("s_waitcnt vmcnt(" #n ")" ::: "memory")
#define PG8_WAIT_L(n) asm volatile("s_waitcnt lgkmcnt(" #n ")" ::: "memory")
#define PG8_BAR __builtin_amdgcn_s_barrier()
#define PG8_SCHED __builtin_amdgcn_sched_barrier(0)
    Unit cur, nxt; int ui = 0;
    if (!S.next(0, cur)) return;
    f32x4 acc[2][2][4][2];
#pragma unroll
    for (int a = 0; a < 2; ++a)
#pragma unroll
        for (int b = 0; b < 2; ++b)
#pragma unroll
            for (int m = 0; m < 4; ++m)
#pragma unroll
                for (int n = 0; n < 2; ++n) acc[a][b][m][n] = (f32x4){0.f, 0.f, 0.f, 0.f};
    bf16x8 At[4][2], B0[2][2], B1[2][2];
    const char* cA = (const char*)g.A + (size_t)cur.pm * tstep + cur.ko; const char* cB = (const char*)g.Bt + (size_t)cur.pn * tstep + cur.ko;
    S.a_ready(cur);
    if constexpr (SP2) {
        PG8_STAGE(PG8_SB(0, 0), cB, voffB); PG8_STAGE(PG8_SB(0, 1), cB + hstep, voffB); PG8_STAGE(PG8_SA(0, 0), cA, voffA); PG8_STAGE(PG8_SA(0, 1), cA + hstep, voffA);
        if (wr == 1) PG8_BAR;
        PG8_WAIT_V(2); PG8_BAR;
        PG8_STAGE(PG8_SB(1, 0), cB + kstep, voffB); PG8_STAGE(PG8_SA(1, 0), cA + kstep, voffA); PG8_STAGE(PG8_SB(1, 1), cB + hstep + kstep, voffB);
        PG8_WAIT_V(6); PG8_BAR;
    } else {
        PG8_STAGE(PG8_SB(0, 0), cB, voffB); PG8_STAGE(PG8_SA(0, 0), cA, voffA); PG8_STAGE(PG8_SB(0, 1), cB + hstep, voffB); PG8_STAGE(PG8_SA(0, 1), cA + hstep, voffA);
        if (wr == 1) PG8_BAR;
        PG8_WAIT_V(4); PG8_BAR;
        PG8_STAGE(PG8_SB(1, 0), cB + kstep, voffB); PG8_STAGE(PG8_SA(1, 0), cA + kstep, voffA); PG8_STAGE(PG8_SB(1, 1), cB + hstep + kstep, voffB);
        PG8_WAIT_V(6); PG8_BAR;
    }
    for (;;) {
        const bool has_next = S.next(ui + 1, nxt);
        const char* nA = has_next ? (const char*)g.A + (size_t)nxt.pm * tstep + nxt.ko : cA; const char* nB = has_next ? (const char*)g.Bt + (size_t)nxt.pn * tstep + nxt.ko : cB;
        for (int t = 0; t < nt; t += 2) {
            const bool last = (t == nt - 2);
            const char* a1 = cA + (size_t)(t + 1) * kstep;
            const char* a2 = last ? nA : cA + (size_t)(t + 2) * kstep; const char* b2 = last ? nB : cB + (size_t)(t + 2) * kstep;
            const char* a3 = a2 + kstep; const char* b3 = b2 + kstep;
            if (last && has_next) S.a_ready(nxt);
            if constexpr (SP2) {
            PG8_LDB(B0, 0, 0); PG8_LDB(B1, 0, 1); PG8_SCHED; PG8_LDA(At, 0, 0); PG8_STAGE(PG8_SA(1, 1), a1 + hstep, voffA);
            PG8_WAIT_V(8); PG8_WAIT_L(0); PG8_BAR; PG8_MMA(0, 0, At, B0); PG8_MMA(0, 1, At, B1); PG8_BAR; PG8_SCHED;
            PG8_LDA(At, 0, 1); PG8_STAGE(PG8_SB(0, 0), b2, voffB); PG8_STAGE(PG8_SB(0, 1), b2 + hstep, voffB); PG8_STAGE(PG8_SA(0, 0), a2, voffA);
            PG8_WAIT_V(8); PG8_WAIT_L(0); PG8_BAR; PG8_MMA(1, 0, At, B0); PG8_MMA(1, 1, At, B1); PG8_BAR; PG8_SCHED;
            PG8_LDB(B0, 1, 0); PG8_LDB(B1, 1, 1); PG8_SCHED; PG8_LDA(At, 1, 0); PG8_STAGE(PG8_SA(0, 1), a2 + hstep, voffA);
            PG8_WAIT_V(8); PG8_WAIT_L(0); PG8_BAR; PG8_MMA(0, 0, At, B0); PG8_MMA(0, 1, At, B1); PG8_BAR; PG8_SCHED;
            PG8_LDA(At, 1, 1); PG8_STAGE(PG8_SB(1, 0), b3, voffB); PG8_STAGE(PG8_SB(1, 1), b3 + hstep, voffB); PG8_STAGE(PG8_SA(1, 0), a3, voffA);
            PG8_WAIT_V(8); PG8_WAIT_L(0); PG8_BAR; PG8_MMA(1, 0, At, B0); PG8_MMA(1, 1, At, B1); PG8_BAR; PG8_SCHED;
            } else {
            PG8_LDB(B0, 0, 0); PG8_SCHED; PG8_LDA(At, 0, 0); PG8_STAGE(PG8_SA(1, 1), a1 + hstep, voffA);
            PG8_WAIT_L(8); PG8_BAR; PG8_WAIT_L(0); PG8_MMA(0, 0, At, B0); PG8_BAR; PG8_SCHED;
            PG8_LDB(B1, 0, 1); PG8_STAGE(PG8_SB(0, 0), b2, voffB);
            PG8_BAR; PG8_WAIT_L(0); PG8_MMA(0, 1, At, B1); PG8_BAR;
            PG8_LDA(At, 0, 1); PG8_STAGE(PG8_SA(0, 0), a2, voffA);
            PG8_BAR; PG8_WAIT_L(0); PG8_MMA(1, 0, At, B0); PG8_BAR; PG8_SCHED;
            PG8_STAGE(PG8_SB(0, 1), b2 + hstep, voffB);
            PG8_WAIT_V(6); PG8_BAR; PG8_MMA(1, 1, At, B1); PG8_BAR;
            PG8_LDB(B0, 1, 0); PG8_SCHED; PG8_LDA(At, 1, 0); PG8_STAGE(PG8_SA(0, 1), a2 + hstep, voffA);
            PG8_WAIT_L(8); PG8_BAR; PG8_WAIT_L(0); PG8_MMA(0, 0, At, B0); PG8_BAR; PG8_SCHED;
            PG8_LDB(B1, 1, 1); PG8_STAGE(PG8_SB(1, 0), b3, voffB);
            PG8_BAR; PG8_WAIT_L(0); PG8_MMA(0, 1, At, B1); PG8_BAR;
            PG8_LDA(At, 1, 1); PG8_STAGE(PG8_SA(1, 0), a3, voffA);
            PG8_BAR; PG8_WAIT_L(0); PG8_MMA(1, 0, At, B0); PG8_BAR; PG8_SCHED;
            PG8_STAGE(PG8_SB(1, 1), b3 + hstep, voffB);
            PG8_WAIT_V(6); PG8_BAR; PG8_MMA(1, 1, At, B1); PG8_BAR;
            }
        }
        if constexpr (ALIGN_EPI) { if (wr == 0) PG8_BAR; }
        if constexpr (!Epi::AFTER_DRAIN) { E(acc, cur, wr, wc, fr, fq); S.done(cur); }
        if (!has_next) break;
#pragma unroll
        for (int a = 0; a < 2; ++a)
#pragma unroll
            for (int b = 0; b < 2; ++b)
#pragma unroll
                for (int m = 0; m < 4; ++m)
#pragma unroll
                    for (int n = 0; n < 2; ++n) acc[a][b][m][n] = (f32x4){0.f, 0.f, 0.f, 0.f};
        cur = nxt; cA = nA; cB = nB; ++ui;
        if constexpr (ALIGN_EPI) { if (wr == 1) PG8_BAR; }
    }
    PG8_WAIT_V(0);
    if constexpr (!ALIGN_EPI) { if (wr == 0) PG8_BAR; }
    PG8_BAR;
    if constexpr (Epi::AFTER_DRAIN) { E.fused(acc, cur, wr, wc, fr, fq, lds, wid, lane); S.done(cur); }
#undef PG8_SA
#undef PG8_SB
#undef PG8_STAGE
#undef PG8_LDA
#undef PG8_LDB
#undef PG8_MMA
#undef PG8_WAIT_V
#undef PG8_WAIT_L
#undef PG8_BAR
#undef PG8_SCHED
}
}

struct EpGU {
    static constexpr bool PERM = true, AFTER_DRAIN = false; bf16* act;
    __device__ __forceinline__ void operator()(const f32x4 (&acc)[2][2][4][2], const pg8::Unit& u, int wr, int wc, int fr, int fq) const {
        const int f0 = u.pn * 128 + wc * 32 + fq * 8;
#pragma unroll
        for (int ai = 0; ai < 2; ++ai)
#pragma unroll
            for (int m = 0; m < 4; ++m) {
                const int row = u.pm * 256 + ai * 128 + wr * 64 + m * 16 + fr;
                const f32x4 g0 = acc[ai][0][m][0], g1 = acc[ai][0][m][1], u0 = acc[ai][1][m][0], u1 = acc[ai][1][m][1];
                uint4 o;
                o.x = pk2(silu_f(g0[0]) * u0[0], silu_f(g0[1]) * u0[1]); o.y = pk2(silu_f(g0[2]) * u0[2], silu_f(g0[3]) * u0[3]);
                o.z = pk2(silu_f(g1[0]) * u1[0], silu_f(g1[1]) * u1[1]); o.w = pk2(silu_f(g1[2]) * u1[2], silu_f(g1[3]) * u1[3]);
                *(uint4*)(act + (size_t)row * 2816 + f0) = o;
            }
    }
};
struct EpPart {
    static constexpr bool PERM = true, AFTER_DRAIN = false; bf16* part;
    __device__ __forceinline__ void operator()(const f32x4 (&acc)[2][2][4][2], const pg8::Unit& u, int wr, int wc, int fr, int fq) const {
        bf16* base = part + (u.ko ? 8388608 : 0);
#pragma unroll
        for (int ai = 0; ai < 2; ++ai)
#pragma unroll
            for (int m = 0; m < 4; ++m) {
                const int row = u.pm * 256 + ai * 128 + wr * 64 + m * 16 + fr;
#pragma unroll
                for (int bj = 0; bj < 2; ++bj) {
                    const f32x4 v0 = acc[ai][bj][m][0], v1 = acc[ai][bj][m][1];
                    uint4 o; o.x = pk2(v0[0], v0[1]); o.y = pk2(v0[2], v0[3]); o.z = pk2(v1[0], v1[1]); o.w = pk2(v1[2], v1[3]);
                    *(uint4*)(base + (size_t)row * 1024 + u.pn * 256 + bj * 128 + wc * 32 + fq * 8) = o;
                }
            }
    }
};
struct EpIn0 {
    static constexpr bool PERM = true, AFTER_DRAIN = false; bf16* proj; float* gates;
    __device__ __forceinline__ void operator()(const f32x4 (&acc)[2][2][4][2], const pg8::Unit& u, int wr, int wc, int fr, int fq) const {
#pragma unroll
        for (int bj = 0; bj < 2; ++bj) {
            const int c0 = u.pn * 256 + bj * 128 + wc * 32 + fq * 8;
            if (c0 < 3616) {
                int gi = -1;
                if (c0 >= 1536 && c0 < 1552) gi = c0 - 1536; else if (c0 >= 3600) gi = 16 + c0 - 3600;
#pragma unroll
                for (int ai = 0; ai < 2; ++ai)
#pragma unroll
                    for (int m = 0; m < 4; ++m) {
                        const int row = u.pm * 256 + ai * 128 + wr * 64 + m * 16 + fr;
                        const f32x4 v0 = acc[ai][bj][m][0], v1 = acc[ai][bj][m][1];
                        uint4 o; o.x = pk2(v0[0], v0[1]); o.y = pk2(v0[2], v0[3]); o.z = pk2(v1[0], v1[1]); o.w = pk2(v1[2], v1[3]);
                        *(uint4*)(proj + (size_t)row * 3616 + c0) = o;
                        if (gi >= 0) { *(f32x4*)(gates + row * 32 + gi) = v0; *(f32x4*)(gates + row * 32 + gi + 4) = v1; }
                    }
            }
        }
    }
};
struct EpIn1 {
    static constexpr bool PERM = true, AFTER_DRAIN = false; bf16* Q; bf16* Kb; bf16* VT; float* outk; float* outv;
    __device__ __forceinline__ void operator()(const f32x4 (&acc)[2][2][4][2], const pg8::Unit& u, int wr, int wc, int fr, int fq) const {
#pragma unroll
        for (int bj = 0; bj < 2; ++bj) {
            const int c0 = u.pn * 256 + bj * 128 + wc * 32 + fq * 8, sec = c0 >> 10, c2 = c0 & 1023, h = c2 >> 6, d0 = c2 & 63;
#pragma unroll
            for (int ai = 0; ai < 2; ++ai)
#pragma unroll
                for (int m = 0; m < 4; ++m) {
                    const int row = u.pm * 256 + ai * 128 + wr * 64 + m * 16 + fr;
                    const f32x4 v0 = acc[ai][bj][m][0], v1 = acc[ai][bj][m][1];
                    if (sec == 0) {
                        uint4 o; o.x = pk2(v0[0] * 0.125f, v0[1] * 0.125f); o.y = pk2(v0[2] * 0.125f, v0[3] * 0.125f); o.z = pk2(v1[0] * 0.125f, v1[1] * 0.125f); o.w = pk2(v1[2] * 0.125f, v1[3] * 0.125f);
                        *(uint4*)(Q + (size_t)row * 1024 + c2) = o;
                    } else if (sec == 1) {
                        uint4 o; o.x = pk2(v0[0], v0[1]); o.y = pk2(v0[2], v0[3]); o.z = pk2(v1[0], v1[1]); o.w = pk2(v1[2], v1[3]);
                        *(uint4*)(Kb + (size_t)row * 1024 + c2) = o;
                        if (row < 4096) { float* ok = outk + ((size_t)((row >> 8) * 16 + h) * 256 + (row & 255)) * 64 + d0; __builtin_nontemporal_store(v0, (f32x4*)ok); __builtin_nontemporal_store(v1, (f32x4*)(ok + 4)); }
                    } else {
                        if (row < 4096) {
                            const int b = row >> 8, t = row & 255;
                            bf16* vp = VT + ((size_t)(b * 16 + h) * 64 + d0) * 256 + t;
#pragma unroll
                            for (int jj = 0; jj < 4; ++jj) { vp[jj * 256] = f2b(v0[jj]); vp[(jj + 4) * 256] = f2b(v1[jj]); }
                            float* ov = outv + ((size_t)(b * 16 + h) * 256 + t) * 64 + d0; __builtin_nontemporal_store(v0, (f32x4*)ov); __builtin_nontemporal_store(v1, (f32x4*)(ov + 4));
                        } else {
                            const int r2 = row - 4096, b = r2 >> 11, t = r2 & 2047;
                            bf16* vp = VT + 4194304 + ((size_t)(b * 16 + h) * 64 + d0) * 2048 + t;
#pragma unroll
                            for (int jj = 0; jj < 4; ++jj) { vp[jj * 2048] = f2b(v0[jj]); vp[(jj + 4) * 2048] = f2b(v1[jj]); }
                        }
                    }
                }
        }
    }
};

__device__ __forceinline__ void adaln_tile(const P& p, unsigned char* smem, int tile) {
    float* sc = (float*)smem; float* red = sc + 3072;
    const int tid = p.tid;
    const float* cctx = p.in[9]; const float* cc = p.in[2];
    for (int i = tid; i < 3072; i += NT) { const int g = i >> 10, k = i & 1023; const float v = (g == 0) ? cctx[k] : cc[(g - 1) * 1024 + k]; sc[i] = silu_f(v); }
    __syncthreads();
    const int l = tile / 144, col0 = (tile % 144) * 64, cl = tid & 15, kg = tid >> 4;
    const float* W = p.in[10] + (size_t)l * 1024 * 9216 + col0 + cl * 4;
    float a0[4] = {0, 0, 0, 0}, a1[4] = {0, 0, 0, 0}, a2[4] = {0, 0, 0, 0};
    for (int k = kg; k < 1024; k += 32) {
        const f32x4 w4_ = __builtin_nontemporal_load((const f32x4*)(W + (size_t)k * 9216)); const float4 w = make_float4(w4_[0], w4_[1], w4_[2], w4_[3]);
        const float s0 = sc[k], s1 = sc[1024 + k], s2 = sc[2048 + k];
        a0[0] += s0 * w.x; a0[1] += s0 * w.y; a0[2] += s0 * w.z; a0[3] += s0 * w.w;
        a1[0] += s1 * w.x; a1[1] += s1 * w.y; a1[2] += s1 * w.z; a1[3] += s1 * w.w;
        a2[0] += s2 * w.x; a2[1] += s2 * w.y; a2[2] += s2 * w.z; a2[3] += s2 * w.w;
    }
#pragma unroll
    for (int j = 0; j < 4; ++j) { red[(kg * 3 + 0) * 64 + cl * 4 + j] = a0[j]; red[(kg * 3 + 1) * 64 + cl * 4 + j] = a1[j]; red[(kg * 3 + 2) * 64 + cl * 4 + j] = a2[j]; }
    __syncthreads();
    if (tid < 192) {
        const int g = tid >> 6, c = tid & 63; float s = 0.f;
        for (int k2 = 0; k2 < 32; ++k2) s += red[(k2 * 3 + g) * 64 + c];
        float* MOD = (float*)(p.ws + WS_MOD);
        MOD[(l * 3 + g) * 9216 + col0 + c] = s + p.in[11][l * 9216 + col0 + c];
    }
    __syncthreads();
}

__device__ __forceinline__ void conv_tile(const float* src, int srcld, bf16* dst, int dstld, int N, int mode, int tk, int tn, unsigned char* smem, int tid) {
    float* t = (float*)smem;
    const int k0 = tk * 128, n0 = tn * 128;
    float4 v[8];
#pragma unroll
    for (int u = 0; u < 8; ++u) {
        const int i = tid + u * NT, kk = i >> 5, n = n0 + (i & 31) * 4;
        v[u] = (float4){0.f, 0.f, 0.f, 0.f};
        if (n < N) { const f32x4 t4 = __builtin_nontemporal_load((const f32x4*)(src + (size_t)(k0 + kk) * srcld + n)); v[u] = make_float4(t4[0], t4[1], t4[2], t4[3]); }
    }
#pragma unroll
    for (int u = 0; u < 8; ++u) {
        const int i = tid + u * NT, kk = i >> 5, n4 = (i & 31) * 4;
        t[kk * 129 + n4] = v[u].x; t[kk * 129 + n4 + 1] = v[u].y; t[kk * 129 + n4 + 2] = v[u].z; t[kk * 129 + n4 + 3] = v[u].w;
    }
    __syncthreads();
    const int nl = tid >> 2, q4 = tid & 3, n = n0 + nl;
    const int row = mode == 0 ? n : (n / 128) * 256 + (n % 128) + (mode == 2 ? 128 : 0);
#pragma unroll
    for (int m = 0; m < 4; ++m) {
        const int kb = q4 * 8 + 32 * m;
        uint4 o;
        o.x = pk2(t[(kb + 0) * 129 + nl], t[(kb + 1) * 129 + nl]); o.y = pk2(t[(kb + 2) * 129 + nl], t[(kb + 3) * 129 + nl]);
        o.z = pk2(t[(kb + 4) * 129 + nl], t[(kb + 5) * 129 + nl]); o.w = pk2(t[(kb + 6) * 129 + nl], t[(kb + 7) * 129 + nl]);
        *(uint4*)(dst + (size_t)row * dstld + k0 + kb) = o;
    }
    __syncthreads();
}
__device__ __forceinline__ int conv_count(int l) { return 4 * 176 + 2 * 176 + 8 * (l == 0 ? 29 : 24) + 64; }
__device__ __forceinline__ void conv_weights_tile(const P& p, unsigned char* smem, int l, int idx) {
    unsigned char* W = p.ws + WS_W;
    const float* src; bf16* dst; int srcld, dstld, N, mode, tk, tn;
    const float* in13 = p.in[13]; const float* in14 = p.in[14]; const float* in16 = p.in[16]; const float* in25 = p.in[25]; const float* in17 = p.in[17]; const float* in26 = p.in[26];
    asm volatile("" : "+s"(in13), "+s"(in14), "+s"(in16), "+s"(in25), "+s"(in17), "+s"(in26));
    if (idx < 4 * 176) {
        const int f = idx / 352, which = (idx / 176) & 1, t = idx % 176; tk = t / 22; tn = t % 22;
        src = (which ? in14 : in13) + (size_t)(l * 2 + f) * 1024 * 2816; srcld = 2816; dst = (bf16*)(W + (f ? W_GU1 : W_GU0)); dstld = 1024; N = 2816; mode = 1 + which;
    } else if (idx < 6 * 176) {
        const int i2 = idx - 4 * 176, f = i2 / 176, t = i2 % 176; tk = t / 8; tn = t % 8;
        src = p.in[15] + (size_t)(l * 2 + f) * 2816 * 1024; srcld = 1024; dst = (bf16*)(W + (f ? W_D1 : W_D0)); dstld = 2816; N = 1024; mode = 0;
    } else {
        const int nin = (l == 0 ? 29 : 24);
        int i2 = idx - 6 * 176;
        if (i2 < 8 * nin) { tk = i2 / nin; tn = i2 % nin; src = l == 0 ? in16 : in25; srcld = N = (l == 0 ? 3616 : 3072); dst = (bf16*)(W + W_IN); dstld = 1024; mode = 0; }
        else { i2 -= 8 * nin; tk = i2 / 8; tn = i2 % 8; src = l == 0 ? in17 : in26; srcld = N = 1024; dst = (bf16*)(W + W_OUT); dstld = 1024; mode = 0; }
    }
    conv_tile(src, srcld, dst, dstld, N, mode, tk, tn, smem, p.tid);
}

__device__ __forceinline__ void ph_prologue(const P& p, unsigned char* smem) {
    for (int t = p.bid; t < 288; t += gridDim.x) adaln_tile(p, smem, t);
    bf16* CK = (bf16*)(p.ws + WS_CK); bf16* CVT = (bf16*)(p.ws + WS_CVT);
    for (int i = p.bid * NT + p.tid; i < 524288; i += gridDim.x * NT) {
        CK[i] = f2b(p.in[7][i]);
        const int d = i & 63, key = (i >> 6) & 255, bh = i >> 14;
        CVT[(bh * 64 + d) * 256 + key] = f2b(p.in[8][i]);
    }
}

__device__ __forceinline__ void ph_norm(const P& p, int l, int j, bool has_res, int resl, int resgi, float coef, bool fin, int rbase, int rend, int rstride, bool x_in) {
    const int lane = p.tid & 63, wave = p.tid >> 6;
    float* X = (float*)(p.ws + WS_X); bf16* HN = (bf16*)(p.ws + WS_HN);
    const float* MOD = (const float*)(p.ws + WS_MOD);
    const bf16* P0 = (const bf16*)(p.ws + WS_R + R_PART); const bf16* P1 = P0 + 8388608;
    const float* g = fin ? p.in[28] : p.in[12] + (l * 3 + j) * 1024;
    float4 v[4][4]; uint2 pa[4][4], pb[4][4];
#pragma unroll
    for (int k = 0; k < 4; ++k) {
        const int row = min(rbase + wave + k * rstride, 8191);
        const float* xs = x_in ? (row < 4096 ? p.in[0] + (size_t)row * 1024 : p.in[1] + (size_t)(row - 4096) * 1024) : X + (size_t)row * 1024;
#pragma unroll
        for (int i = 0; i < 4; ++i) {
            const int c = i * 256 + lane * 4;
            { const f32x4 t4 = __builtin_nontemporal_load((const f32x4*)(xs + c)); v[k][i] = make_float4(t4[0], t4[1], t4[2], t4[3]); }
            if (has_res) { const u32x2 ta = __builtin_nontemporal_load((const u32x2*)(P0 + (size_t)row * 1024 + c)), tb = __builtin_nontemporal_load((const u32x2*)(P1 + (size_t)row * 1024 + c)); pa[k][i] = make_uint2(ta[0], ta[1]); pb[k][i] = make_uint2(tb[0], tb[1]); }
        }
    }
#pragma unroll
    for (int k = 0; k < 4; ++k) {
        const int row = rbase + wave + k * rstride;
        if (row < rend) {
            const int grp = grp_of(row);
            float ss = 0.f;
#pragma unroll
            for (int i = 0; i < 4; ++i) {
                const int c = i * 256 + lane * 4;
                if (has_res) {
                    const uint2 a = pa[k][i], b = pb[k][i];
                    const float4 mg = *(const float4*)(MOD + (resl * 3 + grp) * 9216 + resgi * 1024 + c);
                    v[k][i].x += coef * mg.x * (b2f((bf16)(a.x & 0xffff)) + b2f((bf16)(b.x & 0xffff))); v[k][i].y += coef * mg.y * (b2f((bf16)(a.x >> 16)) + b2f((bf16)(b.x >> 16)));
                    v[k][i].z += coef * mg.z * (b2f((bf16)(a.y & 0xffff)) + b2f((bf16)(b.y & 0xffff))); v[k][i].w += coef * mg.w * (b2f((bf16)(a.y >> 16)) + b2f((bf16)(b.y >> 16)));
                    if (!fin) *(float4*)(X + (size_t)row * 1024 + c) = v[k][i];
                }
                ss += v[k][i].x * v[k][i].x + v[k][i].y * v[k][i].y + v[k][i].z * v[k][i].z + v[k][i].w * v[k][i].w;
            }
#pragma unroll
            for (int o = 32; o >= 1; o >>= 1) ss += __shfl_xor(ss, o);
            const float rs = rsqrtf(ss * (1.f / 1024.f) + 1e-6f);
            if (fin) {
#pragma unroll
                for (int i = 0; i < 4; ++i) {
                    const int c = i * 256 + lane * 4; const float4 gg = *(const float4*)(g + c);
                    float4 o = {v[k][i].x * rs * gg.x, v[k][i].y * rs * gg.y, v[k][i].z * rs * gg.z, v[k][i].w * rs * gg.w};
                    __builtin_nontemporal_store((f32x4){o.x, o.y, o.z, o.w}, (f32x4*)(p.out + (size_t)row * 1024 + c));
                }
            } else {
                const float* mod = MOD + (l * 3 + grp) * 9216;
                const float* sh = mod + (3 * j) * 1024; const float* sc = mod + (3 * j + 1) * 1024;
#pragma unroll
                for (int i = 0; i < 4; ++i) {
                    const int c = i * 256 + lane * 4;
                    const float4 gg = *(const float4*)(g + c), s4 = *(const float4*)(sc + c), h4 = *(const float4*)(sh + c);
                    uint2 o;
                    o.x = pk2(v[k][i].x * rs * gg.x * (1.f + s4.x) + h4.x, v[k][i].y * rs * gg.y * (1.f + s4.y) + h4.y);
                    o.y = pk2(v[k][i].z * rs * gg.z * (1.f + s4.z) + h4.z, v[k][i].w * rs * gg.w * (1.f + s4.w) + h4.w);
                    *(uint2*)(HN + (size_t)row * 1024 + c) = o;
                }
            }
        }
    }
}

struct Chain { int samp, b, dir, h, T, NC, row0; };
__device__ __forceinline__ Chain decode_chain(int chain) {
    Chain c; c.samp = chain < 16; const int c2 = c.samp ? chain : chain - 16;
    c.b = c2 >> 3; c.dir = (c2 >> 2) & 1; c.h = c2 & 3; c.T = c.samp ? 2048 : 256; c.NC = c.T >> 6; c.row0 = c.samp ? 4096 + c.b * 2048 : c.b * 256; return c;
}

__device__ __forceinline__ void item_chunk(int item, int& chain, int& c) { if (item < 512) { chain = item >> 5; c = item & 31; } else { const int i2 = item - 512; chain = 16 + (i2 >> 2); c = i2 & 3; } }

__device__ __forceinline__ void mlstm_m1(const P& p, unsigned char* smem, int item) {
    int chain, c; item_chunk(item, chain, c);
    const Chain ch = decode_chain(chain);
    int tid0 = p.tid; asm volatile("" : "+v"(tid0));
    const int tid = tid0, lane = tid & 63, wave = tid >> 6;
    bf16* sk = (bf16*)smem; bf16* skTw = sk + 64 * 72; bf16* svT = skTw + 64 * 72;
    float* fl = (float*)(svT + 144 * 72);
    float* s_logi = fl; float* s_logf = fl + 64; float* s_wsl = fl + 128;
    const bf16* PROJ = (const bf16*)(p.ws + WS_R + R_PROJ); const float* GATES = (const float*)(p.ws + WS_R + R_GATES);
    float* KV = (float*)(p.ws + WS_R + R_KV) + (size_t)item * 8256; float* MS = (float*)(p.ws + WS_R + R_MS) + item * 4;
    const float bi = p.in[18][ch.dir * 4 + ch.h], bfg = p.in[19][ch.dir * 4 + ch.h];
    lds_barrier();
    for (int i = tid; i < 16 * 72; i += NT) svT[128 * 72 + i] = (i < 64) ? (bf16)0x3F80 : (bf16)0;
    {
        const int i = tid >> 3, seg = tid & 7;
        const int tk = ch.dir == 0 ? c * 64 + i : ch.T - 1 - (c * 64 + i);
        const bf16* rowp = PROJ + (size_t)(ch.row0 + tk) * 3616;
        *(uint4*)(sk + i * 72 + seg * 8) = *(const uint4*)(rowp + 256 + ch.h * 64 + seg * 8);
        {
            const int i2 = tid & 63, vsl = tid >> 6;
            const int tkv = ch.dir == 0 ? c * 64 + i2 : ch.T - 1 - (c * 64 + i2);
            const bf16* vp = PROJ + (size_t)(ch.row0 + tkv) * 3616 + 512 + ch.h * 128 + vsl * 16;
            const uint4 v0 = *(const uint4*)vp, v1 = *(const uint4*)(vp + 8);
            const unsigned vu0[4] = {v0.x, v0.y, v0.z, v0.w}, vu1[4] = {v1.x, v1.y, v1.z, v1.w};
#pragma unroll
            for (int j = 0; j < 4; ++j) {
                svT[(vsl * 16 + 2 * j) * 72 + i2] = (bf16)(vu0[j] & 0xffff); svT[(vsl * 16 + 2 * j + 1) * 72 + i2] = (bf16)(vu0[j] >> 16);
                svT[(vsl * 16 + 8 + 2 * j) * 72 + i2] = (bf16)(vu1[j] & 0xffff); svT[(vsl * 16 + 8 + 2 * j + 1) * 72 + i2] = (bf16)(vu1[j] >> 16);
            }
        }
        if (tid < 64) {
            const int tk2 = ch.dir == 0 ? c * 64 + tid : ch.T - 1 - (c * 64 + tid);
            const float* gp = GATES + (size_t)(ch.row0 + tk2) * 32;
            s_logi[tid] = gp[ch.dir * 4 + ch.h] + bi;
            s_logf[tid] = -softplus_f(-(gp[8 + ch.dir * 4 + ch.h] + bfg));
        }
    }
    lds_barrier();
    if (wave == 0) {
        float bb = s_logf[lane];
#pragma unroll
        for (int o = 1; o < 64; o <<= 1) { const float t = __shfl_up(bb, o); if (lane >= o) bb += t; }
        const float a = s_logi[lane] - bb; float pm = a;
#pragma unroll
        for (int o = 1; o < 64; o <<= 1) { const float t = __shfl_up(pm, o); if (lane >= o) pm = fmaxf(pm, t); }
        const float blast = __shfl(bb, 63), mloc = blast + __shfl(pm, 63);
        s_wsl[lane] = __expf(blast + a - mloc);
        if (lane == 0) { MS[0] = blast; MS[1] = mloc; }
    }
    lds_barrier();
    {
        const int d = tid & 63, s0 = (tid >> 6) * 8; float t8[8];
#pragma unroll
        for (int j = 0; j < 8; ++j) t8[j] = b2f(sk[(s0 + j) * 72 + d]) * s_wsl[s0 + j];
        uint4 o; o.x = pk2(t8[0], t8[1]); o.y = pk2(t8[2], t8[3]); o.z = pk2(t8[4], t8[5]); o.w = pk2(t8[6], t8[7]);
        *(uint4*)(skTw + d * 72 + s0) = o;
    }
    lds_barrier();
    mm<144, 64, 64>(tid, svT, 72, skTw, 72, [&](int, int, int v, int d, float val) { if (v < 129) __builtin_nontemporal_store(val, KV + v * 64 + d); });
}

__device__ __forceinline__ void mlstm_m2(const P& p, int item) {
    const int chain = item / 18, e = (item % 18) * 512 + p.tid, v = e >> 6, d = e & 63;
    const Chain ch = decode_chain(chain);
    const int sidx = (ch.b * 2 + ch.dir) * 4 + ch.h;
    const int base = ch.samp ? chain * 32 : 512 + (chain - 16) * 4;
    const float* KV = (const float*)(p.ws + WS_R + R_KV); float* MS = (float*)(p.ws + WS_R + R_MS);
    bf16* CST = (bf16*)(p.ws + WS_W + W_CST);
    float Cv = 0.f, m = 0.f;
    if (ch.samp) { m = p.in[5][sidx]; if (v < 128) Cv = p.in[3][(size_t)sidx * 8192 + d * 128 + v]; else if (v == 128) Cv = p.in[4][sidx * 64 + d]; }
    for (int c0 = 0; c0 < ch.NC; c0 += 4) {
        float kv[4], bl[4], ml[4];
#pragma unroll
        for (int j = 0; j < 4; ++j) { const int it = base + c0 + j; kv[j] = (v < 129) ? __builtin_nontemporal_load(KV + (size_t)it * 8256 + e) : 0.f; bl[j] = MS[it * 4]; ml[j] = MS[it * 4 + 1]; }
#pragma unroll
        for (int j = 0; j < 4; ++j) {
            const int it = base + c0 + j;
            __builtin_nontemporal_store(f2b(Cv), CST + (size_t)it * 9216 + e);
            if (e == 0) MS[it * 4 + 2] = m;
            const float mnew = fmaxf(bl[j] + m, ml[j]);
            Cv = __expf(bl[j] + m - mnew) * Cv + __expf(ml[j] - mnew) * kv[j];
            m = mnew;
        }
    }
    if (!ch.samp) {
        if (v < 128) p.out[O_C + (size_t)sidx * 8192 + d * 128 + v] = Cv; else if (v == 128) p.out[O_N + sidx * 64 + d] = Cv;
        if (e == 0) p.out[O_M + sidx] = m;
    }
}

__device__ __forceinline__ void mlstm_m3(const P& p, unsigned char* smem, int item) {
    int chain, c; item_chunk(item, chain, c);
    const Chain ch = decode_chain(chain);
    int tid0 = p.tid; asm volatile("" : "+v"(tid0));
    const int tid = tid0, lane = tid & 63, wave = tid >> 6, r = lane & 15, q = lane >> 4;
    bf16* sq = (bf16*)smem; bf16* sk = sq + 64 * 72; bf16* svT = sk + 64 * 72; bf16* ssw = svT + 144 * 72; bf16* sCT = ssw + 64 * 72;
    float* fl = (float*)(sCT + 144 * 72);
    float* s_logi = fl; float* s_logf = fl + 64; float* s_b = fl + 128; float* s_mt = fl + 192; float* s_ai = fl + 256; float* s_den = fl + 320;
    const bf16* PROJ = (const bf16*)(p.ws + WS_R + R_PROJ); const float* GATES = (const float*)(p.ws + WS_R + R_GATES);
    bf16* HM = (bf16*)(p.ws + WS_R + R_HM);
    const bf16* CST = (const bf16*)(p.ws + WS_W + W_CST) + (size_t)item * 9216;
    const float m = ((const float*)(p.ws + WS_R + R_MS))[item * 4 + 2];
    const float bi = p.in[18][ch.dir * 4 + ch.h], bfg = p.in[19][ch.dir * 4 + ch.h];
    lds_barrier();
    for (int i = tid; i < 16 * 72; i += NT) svT[128 * 72 + i] = (i < 64) ? (bf16)0x3F80 : (bf16)0;
    for (int ci = tid; ci < 1152; ci += NT) *(uint4*)(sCT + (ci >> 3) * 72 + (ci & 7) * 8) = ld_nt16(CST + ci * 8);
    {
        const int i = tid >> 3, seg = tid & 7;
        const int tk = ch.dir == 0 ? c * 64 + i : ch.T - 1 - (c * 64 + i);
        const bf16* rowp = PROJ + (size_t)(ch.row0 + tk) * 3616;
        uint4 qv = *(const uint4*)(rowp + ch.h * 64 + seg * 8);
        const uint4 kv = *(const uint4*)(rowp + 256 + ch.h * 64 + seg * 8);
        unsigned* qu = (unsigned*)&qv;
#pragma unroll
        for (int j = 0; j < 4; ++j) { const float lo = b2f((bf16)(qu[j] & 0xffff)) * 0.125f, hi = b2f((bf16)(qu[j] >> 16)) * 0.125f; qu[j] = pk2(lo, hi); }
        *(uint4*)(sq + i * 72 + seg * 8) = qv; *(uint4*)(sk + i * 72 + seg * 8) = kv;
        {
            const int i2 = tid & 63, vsl = tid >> 6;
            const int tkv = ch.dir == 0 ? c * 64 + i2 : ch.T - 1 - (c * 64 + i2);
            const bf16* vp = PROJ + (size_t)(ch.row0 + tkv) * 3616 + 512 + ch.h * 128 + vsl * 16;
            const uint4 v0 = *(const uint4*)vp, v1 = *(const uint4*)(vp + 8);
            const unsigned vu0[4] = {v0.x, v0.y, v0.z, v0.w}, vu1[4] = {v1.x, v1.y, v1.z, v1.w};
#pragma unroll
            for (int j = 0; j < 4; ++j) {
                svT[(vsl * 16 + 2 * j) * 72 + i2] = (bf16)(vu0[j] & 0xffff); svT[(vsl * 16 + 2 * j + 1) * 72 + i2] = (bf16)(vu0[j] >> 16);
                svT[(vsl * 16 + 8 + 2 * j) * 72 + i2] = (bf16)(vu1[j] & 0xffff); svT[(vsl * 16 + 8 + 2 * j + 1) * 72 + i2] = (bf16)(vu1[j] >> 16);
            }
        }
        if (tid < 64) {
            const int tk2 = ch.dir == 0 ? c * 64 + tid : ch.T - 1 - (c * 64 + tid);
            const float* gp = GATES + (size_t)(ch.row0 + tk2) * 32;
            s_logi[tid] = gp[ch.dir * 4 + ch.h] + bi;
            s_logf[tid] = -softplus_f(-(gp[8 + ch.dir * 4 + ch.h] + bfg));
        }
    }
    lds_barrier();
    if (wave == 0) {
        float bb = s_logf[lane];
#pragma unroll
        for (int o = 1; o < 64; o <<= 1) { const float t = __shfl_up(bb, o); if (lane >= o) bb += t; }
        float pm = s_logi[lane] - bb;
#pragma unroll
        for (int o = 1; o < 64; o <<= 1) { const float t = __shfl_up(pm, o); if (lane >= o) pm = fmaxf(pm, t); }
        const float mt = bb + fmaxf(m, pm);
        s_b[lane] = bb; s_mt[lane] = mt; s_ai[lane] = __expf(bb + m - mt);
    }
    lds_barrier();
    const int tm = wave >> 1, vh = wave & 1, tq = tm * 16 + r;
    const bf16x8 qf0 = *(const bf16x8*)(sq + tq * 72 + q * 8), qf1 = *(const bf16x8*)(sq + tq * 72 + 32 + q * 8);
    bf16x8 pb[2];
    {
        f32x4 w4[4];
        const float bt = s_b[tq] - s_mt[tq];
#pragma unroll
        for (int j = 0; j < 4; ++j) {
            if (j <= tm) {
                const bf16x8 kf0 = *(const bf16x8*)(sk + (j * 16 + r) * 72 + q * 8), kf1 = *(const bf16x8*)(sk + (j * 16 + r) * 72 + 32 + q * 8);
                f32x4 z = {0.f, 0.f, 0.f, 0.f};
                z = mfma16(kf0, qf0, z); z = mfma16(kf1, qf1, z);
#pragma unroll
                for (int e = 0; e < 4; ++e) { const int sx = j * 16 + q * 4 + e; w4[j][e] = (sx <= tq) ? z[e] * __expf(bt - s_b[sx] + s_logi[sx]) : 0.f; }
            } else w4[j] = (f32x4){0.f, 0.f, 0.f, 0.f};
        }
#pragma unroll
        for (int ks = 0; ks < 2; ++ks) {
            const u32x4 pu = {pk2(w4[2 * ks][0], w4[2 * ks][1]), pk2(w4[2 * ks][2], w4[2 * ks][3]), pk2(w4[2 * ks + 1][0], w4[2 * ks + 1][1]), pk2(w4[2 * ks + 1][2], w4[2 * ks + 1][3])};
            pb[ks] = __builtin_bit_cast(bf16x8, pu);
        }
    }
    float num[5][4];
    const float ait = s_ai[tq];
#pragma unroll
    for (int it = 0; it < 5; ++it) {
        const int vt = vh * 5 + it;
        if (vt < 9) {
            f32x4 a1 = {0.f, 0.f, 0.f, 0.f}, a2 = {0.f, 0.f, 0.f, 0.f};
            const bf16x8 cf0 = *(const bf16x8*)(sCT + (vt * 16 + r) * 72 + q * 8), cf1 = *(const bf16x8*)(sCT + (vt * 16 + r) * 72 + 32 + q * 8);
            a1 = mfma16(cf0, qf0, a1); a1 = mfma16(cf1, qf1, a1);
#pragma unroll
            for (int ks = 0; ks < 2; ++ks) {
                const uint2 v0 = *(const uint2*)(svT + (vt * 16 + r) * 72 + (2 * ks) * 16 + 4 * q), v1 = *(const uint2*)(svT + (vt * 16 + r) * 72 + (2 * ks + 1) * 16 + 4 * q);
                const u32x4 vau = {v0.x, v0.y, v1.x, v1.y};
                a2 = mfma16(__builtin_bit_cast(bf16x8, vau), pb[ks], a2);
            }
#pragma unroll
            for (int e = 0; e < 4; ++e) num[it][e] = ait * a1[e] + a2[e];
            if (vt == 8 && q == 0) s_den[tq] = num[it][0];
        }
    }
    lds_barrier();
    {
        const float dn = fmaxf(fabsf(s_den[tq]), __expf(-s_mt[tq])), inv = __builtin_amdgcn_rcpf(dn);
        const int tk = ch.dir == 0 ? c * 64 + tq : ch.T - 1 - (c * 64 + tq);
        bf16* hp = HM + ((size_t)ch.dir * 8192 + ch.row0 + tk) * 512 + ch.h * 128 + q * 4;
#pragma unroll
        for (int it = 0; it < 5; ++it) {
            const int vt = vh * 5 + it;
            if (vt < 8) *(uint2*)(hp + vt * 16) = make_uint2(pk2(num[it][0] * inv, num[it][1] * inv), pk2(num[it][2] * inv, num[it][3] * inv));
        }
    }
}

__device__ __forceinline__ void delta_d1(const P& p, unsigned char* smem, int item) {
    int chain, c;
    if (item < 512) { chain = item >> 5; c = item & 31; } else { const int i2 = item - 512; chain = 16 + (i2 >> 2); c = i2 & 3; }
    const Chain ch = decode_chain(chain);
    int tid0 = p.tid; asm volatile("" : "+v"(tid0));
    const int tid = tid0, lane = tid & 63, wave = tid >> 6;
    bf16* raw = (bf16*)smem;
    float* rhs = (float*)smem;
    bf16* skb = (bf16*)(smem + 67584); bf16* skk = skb + 64 * 136; bf16* sqq = skk + 64 * 136;
    float* sA = (float*)(smem + 67584 + 52224);
    float* s_gc = sA + 64 * 68; float* s_beta = s_gc + 64; float* s_g = s_beta + 64;
    float* scw = s_g + 64;
    const bf16* PROJ = (const bf16*)(p.ws + WS_R + R_PROJ); const float* GATES = (const float*)(p.ws + WS_R + R_GATES);
    unsigned char* rec = p.ws + WS_R + R_D1 + (size_t)item * REC;
    bf16* r_u = (bf16*)rec; bf16* r_w = (bf16*)(rec + 16384); bf16* r_qg = (bf16*)(rec + 32768); bf16* r_kdT = (bf16*)(rec + 49152); bf16* r_qk = (bf16*)(rec + 65536);
    const int lo = ch.dir == 0 ? c * 64 : ch.T - 64 - c * 64;
    lds_barrier();
    for (int ci = tid; ci < 3264; ci += NT) {
        const int which = ci / 1088, rem = ci % 1088, rr = rem >> 4, seg = rem & 15, tk = lo - 2 + rr;
        uint4 v = {0u, 0u, 0u, 0u};
        if (tk >= 0 && tk < ch.T) v = *(const uint4*)(PROJ + (size_t)(ch.row0 + tk) * 3616 + 1552 + which * 512 + ch.h * 128 + seg * 8);
        *(uint4*)(raw + (which * 68 + rr) * 160 + seg * 8) = v;
    }
    for (int ci = tid; ci < 1920; ci += NT) { const int j = ci / 384, w = (ci >> 7) % 3, chn = ci & 127; scw[ci] = p.in[21][j * 1536 + w * 512 + ch.h * 128 + chn]; }
    if (tid < 64) {
        const int tk = ch.dir == 0 ? lo + tid : lo + 63 - tid;
        const float* gp = GATES + (size_t)(ch.row0 + tk) * 32;
        s_beta[tid] = sigm_f(gp[16 + ch.dir * 4 + ch.h]);
        s_g[tid] = -__expf(p.in[22][ch.dir * 4 + ch.h]) * softplus_f(gp[24 + ch.dir * 4 + ch.h] + p.in[23][ch.dir * 4 + ch.h]);
    }
    lds_barrier();
    if (wave == 0) {
        float g = s_g[lane];
#pragma unroll
        for (int o = 1; o < 64; o <<= 1) { const float t = __shfl_up(g, o); if (lane >= o) g += t; }
        s_gc[lane] = g;
    }
    const int i = tid >> 3, seg = tid & 7;
    const int tl = ch.dir == 0 ? i : 63 - i;
    float qn[16], kn[16], vv[16];
    {
        const float* cw = scw + seg * 4;
        float sq_ = 0.f, sk_ = 0.f;
#pragma unroll
        for (int w = 0; w < 3; ++w) {
#pragma unroll
            for (int c4 = 0; c4 < 16; c4 += 4) {
                float a4[4] = {0.f, 0.f, 0.f, 0.f};
#pragma unroll
                for (int j = 0; j < 5; ++j) {
                    const float4 wv = *(const float4*)(cw + (j * 3 + w) * 128 + 8 * c4);
                    const uint2 rv = *(const uint2*)(raw + (w * 68 + tl + j) * 160 + seg * 4 + 8 * c4);
                    a4[0] += wv.x * b2f((bf16)(rv.x & 0xffff)); a4[1] += wv.y * b2f((bf16)(rv.x >> 16));
                    a4[2] += wv.z * b2f((bf16)(rv.y & 0xffff)); a4[3] += wv.w * b2f((bf16)(rv.y >> 16));
                }
#pragma unroll
                for (int k = 0; k < 4; ++k) {
                    const float v = silu_f(a4[k]);
                    if (w == 0) { qn[c4 + k] = v; sq_ += v * v; } else if (w == 1) { kn[c4 + k] = v; sk_ += v * v; } else vv[c4 + k] = v;
                }
                __builtin_amdgcn_sched_barrier(0);
            }
        }
        sq_ += __shfl_xor(sq_, 1); sq_ += __shfl_xor(sq_, 2); sq_ += __shfl_xor(sq_, 4);
        sk_ += __shfl_xor(sk_, 1); sk_ += __shfl_xor(sk_, 2); sk_ += __shfl_xor(sk_, 4);
        const float rq = rsqrtf(sq_ + 1e-6f) * 0.08838834764831845f, rk = rsqrtf(sk_ + 1e-6f);
#pragma unroll
        for (int cc = 0; cc < 16; ++cc) { qn[cc] *= rq; kn[cc] *= rk; }
    }
    lds_barrier();
    {
        const float beta = s_beta[i], gci = s_gc[i], egc = __expf(gci);
        unsigned wq[8], wk[8], wb[8], wg[8];
#pragma unroll
        for (int c2 = 0; c2 < 8; ++c2) {
            wq[c2] = pk2(qn[2 * c2], qn[2 * c2 + 1]); wk[c2] = pk2(kn[2 * c2], kn[2 * c2 + 1]);
            wb[c2] = pk2(kn[2 * c2] * beta, kn[2 * c2 + 1] * beta); wg[c2] = pk2(qn[2 * c2] * egc, qn[2 * c2 + 1] * egc);
        }
#pragma unroll
        for (int m = 0; m < 4; ++m) {
            const int cb = 32 * m + 4 * seg; const float be = beta * egc;
            *(uint2*)(sqq + i * 136 + cb) = make_uint2(wq[2 * m], wq[2 * m + 1]);
            *(uint2*)(skk + i * 136 + cb) = make_uint2(wk[2 * m], wk[2 * m + 1]);
            *(uint2*)(skb + i * 136 + cb) = make_uint2(wb[2 * m], wb[2 * m + 1]);
            *(uint2*)(r_qg + i * 128 + cb) = make_uint2(wg[2 * m], wg[2 * m + 1]);
            *(float4*)(rhs + i * 264 + cb) = make_float4(vv[4 * m] * beta, vv[4 * m + 1] * beta, vv[4 * m + 2] * beta, vv[4 * m + 3] * beta);
            *(float4*)(rhs + i * 264 + 128 + cb) = make_float4(kn[4 * m] * be, kn[4 * m + 1] * be, kn[4 * m + 2] * be, kn[4 * m + 3] * be);
        }
        if (tid == 0) *(float*)(rec + 73728) = __expf(s_gc[63]);
    }
    lds_barrier();
    mm<64, 64, 128>(tid, skb, 136, skk, 136, [&](int, int, int t, int s, float val) { sA[t * 68 + s] = (s < t) ? val * __expf(s_gc[t] - s_gc[s]) : 0.f; });
    lds_barrier();
    mm<64, 64, 128>(tid, sqq, 136, skk, 136, [&](int, int, int t, int s, float val) { skb[t * 72 + s] = f2b((s <= t) ? val * __expf(s_gc[t] - s_gc[s]) : 0.f); });
    lds_barrier();
    if (tid >= 256) {
        const int t2 = tid - 256;
#pragma unroll
        for (int u2 = 0; u2 < 2; ++u2) { const int ci = t2 + u2 * 256, row = ci >> 3, sg = ci & 7; *(uint4*)(r_qk + row * 64 + sg * 8) = *(const uint4*)(skb + row * 72 + sg * 8); }
        const int d = t2 & 127, sh = (t2 >> 7) * 32; const float g63 = s_gc[63];
#pragma unroll
        for (int g8 = 0; g8 < 4; ++g8) {
            float kv[8];
#pragma unroll
            for (int jj = 0; jj < 8; ++jj) { const int sx = sh + g8 * 8 + jj; kv[jj] = b2f(skk[sx * 136 + d]) * __expf(g63 - s_gc[sx]); }
            uint4 o; o.x = pk2(kv[0], kv[1]); o.y = pk2(kv[2], kv[3]); o.z = pk2(kv[4], kv[5]); o.w = pk2(kv[6], kv[7]);
            *(uint4*)(r_kdT + d * 64 + sh + g8 * 8) = o;
        }
    }
    float* sD = (float*)sqq;
    if (wave == 0) {
        const int blk = lane >> 4, col = lane & 15;
        float z[16];
#pragma unroll
        for (int ii = 0; ii < 16; ++ii) z[ii] = (ii == col) ? 1.f : 0.f;
#pragma unroll
        for (int ii = 1; ii < 16; ++ii)
#pragma unroll
            for (int s2 = 0; s2 < ii; ++s2) z[ii] -= sA[(blk * 16 + ii) * 68 + blk * 16 + s2] * z[s2];
#pragma unroll
        for (int ii = 0; ii < 16; ++ii) sD[(blk * 16 + ii) * 17 + col] = z[ii];
    }
    lds_barrier();
    {
        const int r = lane & 15, q = lane >> 4;
#pragma unroll
        for (int cti = 0; cti < 2; ++cti) {
            const int c0 = (wave + cti * 8) * 16;
            for (int tb = 0; tb < 4; ++tb) {
                float* cp = rhs + (tb * 16 + q * 4) * 264 + c0 + r;
                f32x4 acc = {cp[0], cp[264], cp[528], cp[792]};
                for (int ks = 0; ks < 4 * tb; ++ks) {
                    const float a = -sA[(tb * 16 + r) * 68 + ks * 4 + q];
                    const float b = rhs[(ks * 4 + q) * 264 + c0 + r];
                    acc = __builtin_amdgcn_mfma_f32_16x16x4f32(a, b, acc, 0, 0, 0);
                }
                cp[0] = acc[0]; cp[264] = acc[1]; cp[528] = acc[2]; cp[792] = acc[3];
                asm volatile("s_waitcnt lgkmcnt(0)" ::: "memory");
                __builtin_amdgcn_wave_barrier();
                f32x4 xv = {0.f, 0.f, 0.f, 0.f};
#pragma unroll
                for (int ks = 0; ks < 4; ++ks) {
                    const float a = sD[(tb * 16 + r) * 17 + ks * 4 + q];
                    const float b = rhs[(tb * 16 + ks * 4 + q) * 264 + c0 + r];
                    xv = __builtin_amdgcn_mfma_f32_16x16x4f32(a, b, xv, 0, 0, 0);
                }
                cp[0] = xv[0]; cp[264] = xv[1]; cp[528] = xv[2]; cp[792] = xv[3];
                asm volatile("s_waitcnt lgkmcnt(0)" ::: "memory");
                __builtin_amdgcn_wave_barrier();
            }
        }
    }
    lds_barrier();
    {
#pragma unroll
        for (int k = 0; k < 4; ++k) {
            const int ci = tid + k * NT, t = ci >> 5, g = ci & 31;
            const float4 x0 = *(const float4*)(rhs + t * 264 + g * 8), x1 = *(const float4*)(rhs + t * 264 + g * 8 + 4);
            uint4 o;
            if (g < 16) { o.x = pk2(x0.x, x0.y); o.y = pk2(x0.z, x0.w); o.z = pk2(x1.x, x1.y); o.w = pk2(x1.z, x1.w); *(uint4*)(r_u + t * 128 + g * 8) = o; }
            else { o.x = pk2(-x0.x, -x0.y); o.y = pk2(-x0.z, -x0.w); o.z = pk2(-x1.x, -x1.y); o.w = pk2(-x1.z, -x1.w); *(uint4*)(r_w + t * 128 + (g - 16) * 8) = o; }
        }
    }
}

__device__ __forceinline__ void delta_d2(const P& p, unsigned char* smem, int item) {
    const int chain = item >> 2, vs = (item & 3) * 32;
    const Chain ch = decode_chain(chain);
    int tid0 = p.tid; asm volatile("" : "+v"(tid0));
    const int tid = tid0, lane = tid & 63, wave = tid >> 6, r = lane & 15, q = lane >> 4;
    bf16* sST = (bf16*)smem; bf16* swn = sST + 32 * 136; bf16* sqg = swn + 64 * 136; bf16* su = sqg + 64 * 136; bf16* skdT = su + 64 * 32; bf16* sqk = skdT + 128 * 72; bf16* svnT = sqk + 64 * 72;
    bf16* HD = (bf16*)(p.ws + WS_R + R_HD);
    const int sidx = (ch.b * 2 + ch.dir) * 4 + ch.h;
    __syncthreads();
    float St[2][4], Ob[4];
#pragma unroll
    for (int it = 0; it < 2; ++it) {
        const int t_ = wave + it * NWV, tm = t_ / 8, tn = t_ % 8;
#pragma unroll
        for (int e = 0; e < 4; ++e) {
            const int v = tm * 16 + q * 4 + e, d = tn * 16 + r;
            const float val = ch.samp ? p.in[6][(size_t)sidx * 16384 + d * 128 + vs + v] : 0.f;
            St[it][e] = val; sST[v * 136 + d] = f2b(val);
        }
    }
    uint4 pb0, pc0, pd0, pb1, pc1, pd1, pq, pu; float gl_n;
#define D2_LOAD(rec_, t_) do { const unsigned char* r_ = (rec_); const int c0_ = (t_), c1_ = (t_) + NT; \
        pb0 = *(const uint4*)(r_ + 16384 + c0_ * 16); pc0 = *(const uint4*)(r_ + 32768 + c0_ * 16); pd0 = *(const uint4*)(r_ + 49152 + c0_ * 16); \
        pb1 = *(const uint4*)(r_ + 16384 + c1_ * 16); pc1 = *(const uint4*)(r_ + 32768 + c1_ * 16); pd1 = *(const uint4*)(r_ + 49152 + c1_ * 16); \
        pq = *(const uint4*)(r_ + 65536 + c0_ * 16); pu = *(const uint4*)(r_ + ((c0_ & 255) >> 2) * 256 + vs * 2 + (c0_ & 3) * 16); gl_n = *(const float*)(r_ + 73728); } while (0)
    const int recbase = ch.samp ? chain * 32 : 512 + (chain - 16) * 4;
    D2_LOAD(p.ws + WS_R + R_D1 + (size_t)recbase * REC, tid);
    for (int c = 0; c < ch.NC; ++c) {
        lds_barrier();
        int tidc = tid0; asm volatile("" : "+v"(tidc));
        const int tid = tidc;
        {
            const int c0 = tid, c1 = tid + NT;
            *(uint4*)(swn + (c0 >> 4) * 136 + (c0 & 15) * 8) = pb0; *(uint4*)(swn + (c1 >> 4) * 136 + (c1 & 15) * 8) = pb1;
            *(uint4*)(sqg + (c0 >> 4) * 136 + (c0 & 15) * 8) = pc0; *(uint4*)(sqg + (c1 >> 4) * 136 + (c1 & 15) * 8) = pc1;
            *(uint4*)(skdT + (c0 >> 3) * 72 + (c0 & 7) * 8) = pd0; *(uint4*)(skdT + (c1 >> 3) * 72 + (c1 & 7) * 8) = pd1;
            *(uint4*)(sqk + (c0 >> 3) * 72 + (c0 & 7) * 8) = pq;
            if (c0 < 256) *(uint4*)(su + (c0 >> 2) * 32 + (c0 & 3) * 8) = pu;
        }
        const float gl = gl_n;
        if (c + 1 < ch.NC) D2_LOAD(p.ws + WS_R + R_D1 + (size_t)(recbase + c + 1) * REC, tid);
        lds_barrier();
        const int lane_ = tid & 63, wave_ = tid >> 6, r_ = lane_ & 15, q_ = lane_ >> 4;
        {
            const int tm = wave_ >> 1, tn = wave_ & 1;
            f32x4 acc1 = {0.f, 0.f, 0.f, 0.f}, acc2 = {0.f, 0.f, 0.f, 0.f};
#pragma unroll
            for (int k = 0; k < 128; k += 32) {
                const bf16x8 bfr = *(const bf16x8*)(sST + (tn * 16 + r_) * 136 + k + q_ * 8);
                const bf16x8 a1 = *(const bf16x8*)(swn + (tm * 16 + r_) * 136 + k + q_ * 8);
                const bf16x8 a2 = *(const bf16x8*)(sqg + (tm * 16 + r_) * 136 + k + q_ * 8);
                acc1 = mfma16(a1, bfr, acc1); acc2 = mfma16(a2, bfr, acc2);
            }
            const int t0 = tm * 16 + q_ * 4, v = tn * 16 + r_;
            const float x0 = b2f(su[t0 * 32 + v]) + acc1[0], x1 = b2f(su[(t0 + 1) * 32 + v]) + acc1[1], x2 = b2f(su[(t0 + 2) * 32 + v]) + acc1[2], x3 = b2f(su[(t0 + 3) * 32 + v]) + acc1[3];
            *(uint2*)(svnT + v * 72 + t0) = make_uint2(pk2(x0, x1), pk2(x2, x3));
            Ob[0] = acc2[0]; Ob[1] = acc2[1]; Ob[2] = acc2[2]; Ob[3] = acc2[3];
        }
        lds_barrier();
        {
            const int tm = wave_ >> 1, tn = wave_ & 1;
            const bf16x8 oa0 = *(const bf16x8*)(sqk + (tm * 16 + r_) * 72 + q_ * 8), oa1 = *(const bf16x8*)(sqk + (tm * 16 + r_) * 72 + 32 + q_ * 8);
            const bf16x8 ob0 = *(const bf16x8*)(svnT + (tn * 16 + r_) * 72 + q_ * 8), ob1 = *(const bf16x8*)(svnT + (tn * 16 + r_) * 72 + 32 + q_ * 8);
            bf16x8 sa[2][2], sb[2][2];
#pragma unroll
            for (int it = 0; it < 2; ++it) {
                const int t_ = wave_ + it * NWV, tm4 = t_ >> 3, tn4 = t_ & 7;
                sa[it][0] = *(const bf16x8*)(svnT + (tm4 * 16 + r_) * 72 + q_ * 8); sa[it][1] = *(const bf16x8*)(svnT + (tm4 * 16 + r_) * 72 + 32 + q_ * 8);
                sb[it][0] = *(const bf16x8*)(skdT + (tn4 * 16 + r_) * 72 + q_ * 8); sb[it][1] = *(const bf16x8*)(skdT + (tn4 * 16 + r_) * 72 + 32 + q_ * 8);
            }
            f32x4 oacc = {0.f, 0.f, 0.f, 0.f};
            oacc = mfma16(oa0, ob0, oacc); oacc = mfma16(oa1, ob1, oacc);
            f32x4 sacc[2];
#pragma unroll
            for (int it = 0; it < 2; ++it) { sacc[it] = (f32x4){0.f, 0.f, 0.f, 0.f}; sacc[it] = mfma16(sa[it][0], sb[it][0], sacc[it]); sacc[it] = mfma16(sa[it][1], sb[it][1], sacc[it]); }
#pragma unroll
            for (int e = 0; e < 4; ++e) {
                const int t = tm * 16 + q_ * 4 + e, v = tn * 16 + r_;
                const int tk = ch.dir == 0 ? c * 64 + t : ch.T - 1 - (c * 64 + t);
                HD[((size_t)ch.dir * 8192 + ch.row0 + tk) * 512 + ch.h * 128 + vs + v] = f2b(Ob[e] + oacc[e]);
            }
#pragma unroll
            for (int it = 0; it < 2; ++it) {
                const int t_ = wave_ + it * NWV, tm4 = t_ >> 3, tn4 = t_ & 7;
#pragma unroll
                for (int e = 0; e < 4; ++e) {
                    const int v = tm4 * 16 + q_ * 4 + e, d = tn4 * 16 + r_;
                    const float nv = gl * St[it][e] + sacc[it][e]; St[it][e] = nv; sST[v * 136 + d] = f2b(nv);
                }
            }
        }
    }
#undef D2_LOAD
    if (!ch.samp) {
#pragma unroll
        for (int it = 0; it < 2; ++it) {
            const int t_ = wave + it * NWV, tm = t_ / 8, tn = t_ % 8;
#pragma unroll
            for (int e = 0; e < 4; ++e) { const int v = tm * 16 + q * 4 + e, d = tn * 16 + r; p.out[O_S + (size_t)sidx * 16384 + d * 128 + vs + v] = St[it][e]; }
        }
    }
}

__device__ __forceinline__ void ph_combine(const P& p) {
    const int lane = p.tid & 63, wave = p.tid >> 6;
    const bf16* PROJ = (const bf16*)(p.ws + WS_R + R_PROJ);
    const bf16* HM = (const bf16*)(p.ws + WS_R + R_HM); const bf16* HD = (const bf16*)(p.ws + WS_R + R_HD);
    bf16* MIX = (bf16*)(p.ws + WS_HN);
    const int col0 = lane * 16;
    const float* gp = (lane < 32) ? p.in[20] + col0 : p.in[24] + ((col0 - 512) & 127);
    float gv[16];
#pragma unroll
    for (int j = 0; j < 4; ++j) { const float4 t = *(const float4*)(gp + 4 * j); gv[4 * j] = t.x; gv[4 * j + 1] = t.y; gv[4 * j + 2] = t.z; gv[4 * j + 3] = t.w; }
    uint4 a0[4], a1[4], b0[4], b1[4], z0[4], z1[4];
#pragma unroll
    for (int k = 0; k < 4; ++k) {
        const int row = min(p.bid * NWV + wave + k * (int)gridDim.x * NWV, 8191);
        const bf16* s0 = (lane < 32) ? HM + (size_t)row * 512 + col0 : HD + (size_t)row * 512 + col0 - 512;
        const bf16* s1 = s0 + (size_t)8192 * 512;
        const bf16* zp = PROJ + (size_t)row * 3616 + ((lane < 32) ? 1024 + col0 : 3088 + col0 - 512);
        a0[k] = ld_nt16(s0); a1[k] = ld_nt16(s0 + 8); b0[k] = ld_nt16(s1); b1[k] = ld_nt16(s1 + 8);
        z0[k] = ld_nt16(zp); z1[k] = ld_nt16(zp + 8);
    }
#pragma unroll
    for (int k = 0; k < 4; ++k) {
        const int row = p.bid * NWV + wave + k * (int)gridDim.x * NWV;
        if (row < 8192) {
            const unsigned ua[8] = {a0[k].x, a0[k].y, a0[k].z, a0[k].w, a1[k].x, a1[k].y, a1[k].z, a1[k].w}, ub[8] = {b0[k].x, b0[k].y, b0[k].z, b0[k].w, b1[k].x, b1[k].y, b1[k].z, b1[k].w};
            const unsigned uz[8] = {z0[k].x, z0[k].y, z0[k].z, z0[k].w, z1[k].x, z1[k].y, z1[k].z, z1[k].w};
            float x[16]; float ss = 0.f;
#pragma unroll
            for (int j = 0; j < 8; ++j) {
                x[2 * j] = b2f((bf16)(ua[j] & 0xffff)) + b2f((bf16)(ub[j] & 0xffff)); x[2 * j + 1] = b2f((bf16)(ua[j] >> 16)) + b2f((bf16)(ub[j] >> 16));
                ss += x[2 * j] * x[2 * j] + x[2 * j + 1] * x[2 * j + 1];
            }
            ss += __shfl_xor(ss, 1); ss += __shfl_xor(ss, 2); ss += __shfl_xor(ss, 4);
            const float rs = rsqrtf(ss * (1.f / 128.f) + 1e-6f);
            float o[16];
#pragma unroll
            for (int j = 0; j < 8; ++j) {
                const float zl = b2f((bf16)(uz[j] & 0xffff)), zh = b2f((bf16)(uz[j] >> 16));
                o[2 * j] = x[2 * j] * rs * gv[2 * j] * ((lane < 32) ? sigm_f(zl) : silu_f(zl));
                o[2 * j + 1] = x[2 * j + 1] * rs * gv[2 * j + 1] * ((lane < 32) ? sigm_f(zh) : silu_f(zh));
            }
            uint4 a, b2;
            a.x = pk2(o[0], o[1]); a.y = pk2(o[2], o[3]); a.z = pk2(o[4], o[5]); a.w = pk2(o[6], o[7]);
            b2.x = pk2(o[8], o[9]); b2.y = pk2(o[10], o[11]); b2.z = pk2(o[12], o[13]); b2.w = pk2(o[14], o[15]);
            *(uint4*)(MIX + (size_t)row * 1024 + col0) = a; *(uint4*)(MIX + (size_t)row * 1024 + col0 + 8) = b2;
        }
    }
}

__device__ __forceinline__ void ph_attn(const P& p, unsigned char* smem) {
    const bf16* Qg = (const bf16*)(p.ws + WS_R + R_Q); const bf16* Kg = (const bf16*)(p.ws + WS_R + R_K); const bf16* VT = (const bf16*)(p.ws + WS_R + R_VT);
    const bf16* CK = (const bf16*)(p.ws + WS_CK); const bf16* CVT = (const bf16*)(p.ws + WS_CVT);
    bf16* MIX = (bf16*)(p.ws + WS_HN);
    const int pswz = (gridDim.x == 256) ? ((p.bid & 7) * 32 + (p.bid >> 3)) : p.bid;
    for (int pair = pswz; pair < 1024; pair += gridDim.x) {
        int tidc = p.tid; asm volatile("" : "+v"(tidc));
        const int tid = tidc, lane = tid & 63, wave = tid >> 6, r = lane & 15, q = lane >> 4;
        const int half = wave >> 2, wq = wave & 3, tl = tid & 255;
        unsigned char* base = smem + half * 64512;
        bf16* sQ = (bf16*)base; bf16* sK = sQ + 64 * 72; bf16* sV = sK + 128 * 72; bf16* sP = sV + 64 * 136 + wq * 16 * 136;
        float* sBias = (float*)(base + 62464);
        const int item = pair * 2 + half; const bool samp = item >= 1024;
        int b, h, qrow0, ntile, gr = 0, kr0 = 0;
        if (!samp) { b = item >> 6; h = (item >> 2) & 15; qrow0 = b * 256 + (item & 3) * 64; ntile = 2; }
        else { const int i2 = item - 1024; b = i2 >> 9; h = (i2 >> 5) & 15; gr = i2 & 31; qrow0 = 4096 + b * 2048 + gr * 64; ntile = 6; kr0 = min(max(gr - 4, 0), 24); }
        __syncthreads();
#pragma unroll
        for (int i = 0; i < 2; ++i) { const int c = tl + i * 256, row = c >> 3, seg = c & 7; *(uint4*)(sQ + row * 72 + seg * 8) = ld_nt16(Qg + (size_t)(qrow0 + row) * 1024 + h * 64 + seg * 8); }
        if (samp) for (int i = tl; i < 465; i += 256) sBias[i] = p.in[27][h * 465 + i];
        float m_run = -1e30f, l_run = 0.f;
        f32x4 O[4];
#pragma unroll
        for (int j = 0; j < 4; ++j) O[j] = (f32x4){0.f, 0.f, 0.f, 0.f};
        uint4 rk0, rk1, rk2, rk3, rv0, rv1, rv2, rv3;
#define ATT_LD1(kt_, i_, RK, RV) do { const int c = tl + (i_) * 256; \
            { const int key = c >> 3, seg = c & 7; const bf16* src; \
              if (!samp) src = Kg + (size_t)(b * 256 + (kt_) * 128 + key) * 1024 + h * 64 + seg * 8; \
              else if ((kt_) < 2) src = CK + (size_t)((b * 16 + h) * 256 + (kt_) * 128 + key) * 64 + seg * 8; \
              else src = Kg + (size_t)(4096 + b * 2048 + (kr0 + ((kt_) - 2) * 2) * 64 + key) * 1024 + h * 64 + seg * 8; \
              RK = *(const uint4*)src; } \
            { const int d = c >> 4, seg = c & 15; const bf16* src; \
              if (!samp) src = VT + ((size_t)(b * 16 + h) * 64 + d) * 256 + (kt_) * 128 + seg * 8; \
              else if ((kt_) < 2) src = CVT + ((size_t)(b * 16 + h) * 64 + d) * 256 + (kt_) * 128 + seg * 8; \
              else src = VT + 4194304 + ((size_t)(b * 16 + h) * 64 + d) * 2048 + (kr0 + ((kt_) - 2) * 2) * 64 + seg * 8; \
              RV = *(const uint4*)src; } } while (0)
#define ATT_LOAD(kt_) do { ATT_LD1(kt_, 0, rk0, rv0); ATT_LD1(kt_, 1, rk1, rv1); ATT_LD1(kt_, 2, rk2, rv2); ATT_LD1(kt_, 3, rk3, rv3); } while (0)
#define ATT_ST1(i_, RK, RV) do { const int c = tl + (i_) * 256; *(uint4*)(sK + (c >> 3) * 72 + (c & 7) * 8) = RK; *(uint4*)(sV + (c >> 4) * 136 + (c & 15) * 8) = RV; } while (0)
        ATT_LOAD(0);
        for (int kt = 0; kt < ntile; ++kt) {
            lds_barrier();
            ATT_ST1(0, rk0, rv0); ATT_ST1(1, rk1, rv1); ATT_ST1(2, rk2, rv2); ATT_ST1(3, rk3, rv3);
            if (kt + 1 < ntile) ATT_LOAD(kt + 1);
            lds_barrier();
            f32x4 s[8];
            {
                const bf16x8 qf0 = *(const bf16x8*)(sQ + (wq * 16 + r) * 72 + q * 8), qf1 = *(const bf16x8*)(sQ + (wq * 16 + r) * 72 + 32 + q * 8);
#pragma unroll
                for (int j = 0; j < 8; ++j) {
                    const bf16x8 kf0 = *(const bf16x8*)(sK + (j * 16 + r) * 72 + q * 8), kf1 = *(const bf16x8*)(sK + (j * 16 + r) * 72 + 32 + q * 8);
                    f32x4 z = {0.f, 0.f, 0.f, 0.f};
                    z = mfma16(kf0, qf0, z); s[j] = mfma16(kf1, qf1, z);
                }
            }
            if (samp && kt >= 2) {
                const int qc = wq * 16 + r, cs = min(max(qc - 8, 0), 48);
#pragma unroll
                for (int j = 0; j < 8; ++j) {
#pragma unroll
                    for (int e = 0; e < 4; ++e) {
                        const int kk = j * 16 + q * 4 + e, krow = kr0 + (kt - 2) * 2 + (kk >> 6), kc = kk & 63;
                        const bool valid = (unsigned)(kc - cs) < 16u;
                        s[j][e] = valid ? s[j][e] + sBias[valid ? (krow - gr + 7) * 31 + kc + 15 - qc : 0] : -1e30f;
                    }
                }
            }
            {
                float mx = s[0][0];
#pragma unroll
                for (int j = 0; j < 8; ++j)
#pragma unroll
                    for (int e = 0; e < 4; ++e) mx = fmaxf(mx, s[j][e]);
                mx = fmaxf(mx, __shfl_xor(mx, 16)); mx = fmaxf(mx, __shfl_xor(mx, 32));
                const float mn = fmaxf(m_run, mx), alpha = __expf(m_run - mn);
                m_run = mn;
                float rs = 0.f;
#pragma unroll
                for (int j = 0; j < 8; ++j)
#pragma unroll
                    for (int e = 0; e < 4; ++e) { const float pv = __expf(s[j][e] - mn); s[j][e] = pv; rs += pv; }
                rs += __shfl_xor(rs, 16); rs += __shfl_xor(rs, 32);
                l_run = l_run * alpha + rs;
#pragma unroll
                for (int jn = 0; jn < 4; ++jn) O[jn] = O[jn] * alpha;
            }
#pragma unroll
            for (int ks = 0; ks < 4; ++ks) {
                const u32x4 pbu = {pk2(s[2 * ks][0], s[2 * ks][1]), pk2(s[2 * ks][2], s[2 * ks][3]), pk2(s[2 * ks + 1][0], s[2 * ks + 1][1]), pk2(s[2 * ks + 1][2], s[2 * ks + 1][3])};
                const bf16x8 pb = __builtin_bit_cast(bf16x8, pbu);
#pragma unroll
                for (int jn = 0; jn < 4; ++jn) {
                    const uint2 v0 = *(const uint2*)(sV + (jn * 16 + r) * 136 + (2 * ks) * 16 + 4 * q), v1 = *(const uint2*)(sV + (jn * 16 + r) * 136 + (2 * ks + 1) * 16 + 4 * q);
                    const u32x4 vau = {v0.x, v0.y, v1.x, v1.y};
                    O[jn] = mfma16(__builtin_bit_cast(bf16x8, vau), pb, O[jn]);
                }
            }
        }
        {
            const float inv = __builtin_amdgcn_rcpf(l_run);
#pragma unroll
            for (int jn = 0; jn < 4; ++jn)
                *(uint2*)(MIX + (size_t)(qrow0 + wq * 16 + r) * 1024 + h * 64 + jn * 16 + q * 4) = make_uint2(pk2(O[jn][0] * inv, O[jn][1] * inv), pk2(O[jn][2] * inv, O[jn][3] * inv));
        }
    }
}


#define XB_TMO      128
#define XB_XCNT(j)  (256  + 64 * (j))
#define XB_XSUB(j)  (1280 + 64 * (j))
#define XB_XGEN(j)  (2304 + 64 * (j))
#define XB_TOP      3328
#define XB_TOPGEN   3392
#define XCD_BAR_WORDS 3456
#define XB_SPIN_CAP (1u << 22)
#define LAS __attribute__((address_space(3)))
__device__ __forceinline__ unsigned xb_ld(unsigned* p)              { return __hip_atomic_load(p, __ATOMIC_RELAXED, __HIP_MEMORY_SCOPE_AGENT); }
__device__ __forceinline__ unsigned xb_add(unsigned* p, unsigned v) { return __hip_atomic_fetch_add(p, v, __ATOMIC_RELAXED, __HIP_MEMORY_SCOPE_AGENT); }
__device__ __forceinline__ unsigned xb_xcc_id() { return (unsigned)__builtin_amdgcn_s_getreg((3 << 11) | 20) & 0xFu; }
#define XB_SPIN(cond, bar) do { unsigned _sp = 0; while (cond) { __builtin_amdgcn_s_sleep(1); \
    if ((++_sp & 255u) == 0u) { if (xb_ld(&(bar)[XB_TMO])) break; if (_sp > XB_SPIN_CAP) { atomicAdd(&(bar)[XB_TMO], 1u); break; } } } } while (0)
struct XcdBarrier { unsigned* bar; unsigned x; volatile LAS unsigned* st; };
__device__ __forceinline__ XcdBarrier xcd_barrier_post(unsigned* bar, volatile LAS unsigned* st) {
    XcdBarrier b; b.bar = bar; b.x = xb_xcc_id(); b.st = st;
    if (threadIdx.x == 0) (void)xb_add(&bar[XB_XCNT(b.x)], 1u);
    return b;
}
__device__ __forceinline__ void xcd_barrier_complete(unsigned* bar, unsigned x, unsigned& nloc, unsigned& nx) {
    const unsigned G = gridDim.x * gridDim.y * gridDim.z;
    unsigned sum, cnt, mine, sp = 0u;
    for (;;) {
        sum = 0u; cnt = 0u; mine = 0u;
#pragma unroll
        for (unsigned j = 0; j < 16; ++j) { const unsigned c = xb_ld(&bar[XB_XCNT(j)]); sum += c; cnt += (c > 0u) ? 1u : 0u; mine = (j == x) ? c : mine; }
        if (sum == G) break;
        __builtin_amdgcn_s_sleep(1);
        if ((++sp & 255u) == 0u) { if (xb_ld(&bar[XB_TMO])) break; if (sp > XB_SPIN_CAP) { atomicAdd(&bar[XB_TMO], 1u); break; } }
    }
    nloc = mine > 0u ? mine : 1u; nx = cnt > 0u ? cnt : 1u;
}
__device__ __forceinline__ void xcd_barrier(const XcdBarrier& b) {
    asm volatile("s_waitcnt vmcnt(0)" ::: "memory");
    __syncthreads();
    if (threadIdx.x == 0) {
        unsigned* bar = b.bar;
        __builtin_amdgcn_s_waitcnt(0);
        unsigned nloc = b.st[0], nx = b.st[1];
        if (nloc == 0u) { xcd_barrier_complete(bar, b.x, nloc, nx); b.st[0] = nloc; b.st[1] = nx; }
        const unsigned old = xb_add(&bar[XB_XSUB(b.x)], 1u);
        const unsigned gen = old / nloc;
        if (old + 1u == (gen + 1u) * nloc) {
            __builtin_amdgcn_fence(__ATOMIC_RELEASE, "agent");
            asm volatile("s_waitcnt vmcnt(0)" ::: "memory");
            const unsigned og = xb_add(&bar[XB_TOP], 1u);
            const unsigned tg = og / nx;
            if (og + 1u == (tg + 1u) * nx) xb_add(&bar[XB_TOPGEN], 1u);
            else XB_SPIN(xb_ld(&bar[XB_TOPGEN]) == tg, bar);
            __builtin_amdgcn_fence(__ATOMIC_ACQUIRE, "agent");
            xb_add(&bar[XB_XGEN(b.x)], 1u);
            asm volatile("s_waitcnt vmcnt(0)" ::: "memory");
        } else {
            XB_SPIN(xb_ld(&bar[XB_XGEN(b.x)]) == gen, bar);
            __builtin_amdgcn_fence(__ATOMIC_ACQUIRE, "agent");
            asm volatile("s_waitcnt vmcnt(0)" ::: "memory");
        }
    }
    __syncthreads();
}

#define PANEL_CNT_WORD 3584
__device__ __forceinline__ void panel_wait(unsigned* cnt) {
    asm volatile("s_waitcnt vmcnt(0)" ::: "memory");
    __syncthreads();
    if (threadIdx.x == 0) {
        __builtin_amdgcn_fence(__ATOMIC_RELEASE, "agent");
        asm volatile("s_waitcnt vmcnt(0)" ::: "memory");
        xb_add(cnt, 1u);
        unsigned sp = 0;
        while (xb_ld(cnt) < 8u) { __builtin_amdgcn_s_sleep(1); if (++sp > (1u << 24)) break; }
        __builtin_amdgcn_fence(__ATOMIC_ACQUIRE, "agent");
        asm volatile("s_waitcnt vmcnt(0)" ::: "memory");
    }
    __syncthreads();
}
#ifdef ONLY
#define EN(x) ((x) == ONLY)
#else
#define EN(x) true
#endif
constexpr int PPL = 13;
constexpr int N_PHASES = 1 + PPL * 2 + 1;
__device__ __forceinline__ void run_phase(P& p, int ph, unsigned char* smem, int rep) {
    int l = 0, s;
    if (ph == 0) s = 20; else if (ph == N_PHASES - 1) s = 21; else { l = (ph - 1) / PPL; s = (ph - 1) % PPL; }
    unsigned char* W = p.ws + WS_W; unsigned char* R = p.ws + WS_R;
    float* X = (float*)(p.ws + WS_X); const bf16* HN = (const bf16*)(p.ws + WS_HN); const float* MOD = (const float*)(p.ws + WS_MOD);
    PG8_LAS unsigned char* lds = (PG8_LAS unsigned char*)smem;
    bool do_norm = false, fin = false, has_res = false; int nl = l, nj = 0, resgi = 0, rbase = p.bid * NWV, rend = 8192, rstride = (int)gridDim.x * NWV; float coef = 0.5f;
    if (s == 20 || s == 0) {
        if (EN(12) && s == 20) ph_prologue(p, smem);
        if (s == 0 && l == 0) do_norm = true;
        if (EN(14) && (s == 20 || (s == 0 && l == 1))) { const int n = conv_count(l); for (int t = (s == 20) ? (int)((p.bid + gridDim.x - 32) % gridDim.x) : p.bid; t < n; t += gridDim.x) conv_weights_tile(p, smem, l, t); }
    } else if (s == 1 || s == 11) {
        if (EN(1)) {
            EpGU e{(bf16*)(R + R_ACT)}; pg8::StaticOrder S; S.init(8192, 5632, gridDim.x, p.bid);
            pg8::gemm_phase<EpGU, pg8::StaticOrder, true, true>(lds, pg8::Gemm{HN, (const bf16*)(W + (s == 1 ? W_GU0 : W_GU1)), 1024, 1024}, S, e, p.tid);
        }
    } else if (s == 2 || s == 9 || s == 12) {
        if (EN(2)) {
            EpPart e{(bf16*)(R + R_PART)};
            const bf16* A = (s == 9) ? HN : (const bf16*)(R + R_ACT);
            const bf16* Bt = (const bf16*)(W + (s == 9 ? W_OUT : (s == 2 ? W_D0 : W_D1)));
            const int ld = s == 9 ? 1024 : 2816;
            pg8::SplitK2Order S{p.bid, (int)gridDim.x, ld};
            pg8::gemm_phase<EpPart, pg8::SplitK2Order, true, true>(lds, pg8::Gemm{A, Bt, ld, ld / 2}, S, e, p.tid);
            const int pm = 4 * (p.bid & 7) + ((p.bid >> 3) & 3), sub = p.bid >> 5;
            panel_wait((unsigned*)(p.ws + WS_BAR) + PANEL_CNT_WORD + (l * 3 + (s == 2 ? 0 : (s == 9 ? 1 : 2))) * 32 + pm);
            do_norm = true; has_res = true; resgi = s == 2 ? 2 : (s == 9 ? 5 : 8); coef = s == 9 ? 1.0f : 0.5f;
            nj = s == 2 ? 1 : (s == 9 ? 2 : 0); nl = (s == 12) ? l + 1 : l; fin = (s == 12 && l == 1);
            rbase = pm * 256 + sub * 32; rend = rbase + 32; rstride = NWV;
        }
    } else if (s == 4) {
        if (l == 0) {
            if (EN(4)) {
                EpIn0 e{(bf16*)(R + R_PROJ), (float*)(R + R_GATES)}; pg8::StaticOrder S; S.init(8192, 3840, gridDim.x, p.bid);
                pg8::gemm_phase<EpIn0, pg8::StaticOrder, true, true>(lds, pg8::Gemm{HN, (const bf16*)(W + W_IN), 1024, 1024}, S, e, p.tid);
            }
        } else if (EN(15)) {
            EpIn1 e{(bf16*)(R + R_Q), (bf16*)(R + R_K), (bf16*)(R + R_VT), p.out + O_K, p.out + O_V}; pg8::StaticOrder S; S.init(8192, 3072, gridDim.x, p.bid);
            pg8::gemm_phase<EpIn1, pg8::StaticOrder, true, true>(lds, pg8::Gemm{HN, (const bf16*)(W + W_IN), 1024, 1024}, S, e, p.tid);
        }
    } else if (s == 5) {
        if (l == 0) {
            if (EN(5) && !(rep && PROBE == 9)) { { int t = p.tid; asm volatile("" : "+v"(t)); p.tid = t; } for (int t = p.bid; t < 1024; t += gridDim.x) mlstm_m1(p, smem, t); }
            if (EN(16) && !(rep && PROBE == 8)) { { int t = p.tid; asm volatile("" : "+v"(t)); p.tid = t; } for (int t = p.bid; t < 1024; t += gridDim.x) delta_d1(p, smem, t); }
        }
        else if (EN(17)) ph_attn(p, smem);
    } else if (s == 6) {
        if (l == 0) {
            const int nrest = (int)gridDim.x - 64;
            if (EN(18)) { if (nrest > 0) { if (p.bid >= 64) for (int t = p.bid - 64; t < 2592; t += nrest) mlstm_m2(p, t); } else { for (int t = p.bid; t < 2592; t += gridDim.x) mlstm_m2(p, t); } }
            if (EN(6)) {
                { int t = p.tid; asm volatile("" : "+v"(t)); p.tid = t; }
                if (nrest > 0) { for (int t = (p.bid < 64 ? p.bid : p.bid); t < 576; t += (p.bid < 64 ? 576 : nrest)) delta_d2(p, smem, t); }
                else { for (int t = p.bid; t < 576; t += gridDim.x) delta_d2(p, smem, t); }
            }
        }
    } else if (s == 7) {
        if (EN(19) && l == 0) { for (int t = p.bid; t < 1024; t += gridDim.x) mlstm_m3(p, smem, t); }
    } else if (s == 8) {
        if (EN(7) && l == 0) ph_combine(p);
    }
    if (EN(0) && do_norm) ph_norm(p, fin ? 1 : nl, nj, has_res, l, resgi, coef, fin, rbase, rend, rstride, l == 0 && (s == 0 || s == 2));
}
__device__ __forceinline__ bool phase_empty(int ph) {
    if (ph == 0) return false;
    if (ph == N_PHASES - 1) return true;
    const int l = (ph - 1) / PPL, s = (ph - 1) % PPL;
    return s == 3 || s == 10 || (l == 1 && (s == 6 || s == 7 || s == 8));
}


__device__ __forceinline__ bool probe_match(int ph) {
#if PROBE == 0
    return false;
#else
    if (ph == 0) return PROBE == 5;
    if (ph == N_PHASES - 1) return PROBE == 6;
    const int l = (ph - 1) / PPL, s = (ph - 1) % PPL;
    if (PROBE == 1) return s == 1 || s == 4 || s == 11;
    if (PROBE == 11) return l == 1 && s == 0;
    if (PROBE == 12) return l == 0 && s == 8;
    if (PROBE == 2 || PROBE == 8 || PROBE == 9) return l == 0 && s == 5;
    if (PROBE == 3) return l == 0 && s == 6;
    if (PROBE == 4) return l == 1 && s == 5;
    if (PROBE == 6) return s == 0 || s == 3 || s == 10 || (l == 0 && s == 8);
    if (PROBE == 7) return ph == 1;
    if (PROBE == 10) return l == 0 && s == 7;
    return false;
#endif
}
__global__ void __launch_bounds__(NT) mega(P p) {
    extern __shared__ __attribute__((aligned(16))) unsigned char smem[];
    cg::grid_group grid = cg::this_grid();
    if (p.ph_hi > 100000) grid.sync();
    __shared__ uint4 xb_words;
    if (threadIdx.x == 0) xb_words = make_uint4(0u, 0u, 0u, 0u);
    __syncthreads();
    const XcdBarrier xb = xcd_barrier_post((unsigned*)(p.ws + WS_BAR), (volatile LAS unsigned*)&xb_words);
    const int wave_s = __builtin_amdgcn_readfirstlane((int)threadIdx.x >> 6);
    bool first = true;
    for (int ph = p.ph_lo; ph < p.ph_hi; ++ph) {
        if (phase_empty(ph)) continue;
        const int nrep = probe_match(ph) ? 2 : 1;
        for (int rep = 0; rep < nrep; ++rep) {
            if (!first) xcd_barrier(xb);
            first = false;
            { int t = (wave_s << 6) | (int)__builtin_amdgcn_mbcnt_hi(~0u, __builtin_amdgcn_mbcnt_lo(~0u, 0u)), b = (int)blockIdx.x; asm volatile("" : "+v"(t)); asm volatile("" : "+s"(b)); p.tid = t; p.bid = b; }
#if PROBE == 7
            if (rep) { for (int k = 0; k < 9; ++k) xcd_barrier(xb); continue; }
#endif
            run_phase(p, ph, smem, rep);
        }
    }
}

extern "C" void kernel_launch(void* const* d_in, const int* in_sizes, int n_in, void* d_out, int out_size, void* d_ws, size_t ws_size, hipStream_t stream) {
    static int grid_blocks = 0;
    if (!grid_blocks) {
        if (n_in != 29 || ws_size < WS_END) { fprintf(stderr, "kernel_launch: need 29 inputs and %zu B of workspace; got %d, %zu\n", (size_t)WS_END, n_in, ws_size); grid_blocks = -1; return; }
        int dev = 0, cus = 0, per_cu = 0;
        hipGetDevice(&dev);
        hipDeviceGetAttribute(&cus, hipDeviceAttributeMultiprocessorCount, dev);
        if (hipFuncSetAttribute((const void*)mega, hipFuncAttributeMaxDynamicSharedMemorySize, LDS_BYTES) != hipSuccess) { fprintf(stderr, "hipFuncSetAttribute failed\n"); grid_blocks = -1; return; }
        if (hipOccupancyMaxActiveBlocksPerMultiprocessor(&per_cu, (const void*)mega, NT, LDS_BYTES) != hipSuccess || per_cu < 1) { fprintf(stderr, "occupancy query failed (%d)\n", per_cu); per_cu = 1; (void)hipGetLastError(); }
        grid_blocks = cus * per_cu;
        if (grid_blocks < 256) { fprintf(stderr, "kernel_launch: needs 256 resident workgroups, have %d\n", grid_blocks); grid_blocks = -1; return; }
        grid_blocks = 256;
        fprintf(stderr, "kernel_launch: %d CUs x %d blocks\n", cus, per_cu);
    }
    if (grid_blocks < 0) return;
    if (hipMemsetAsync((char*)d_ws + WS_BAR, 0, 16384, stream) != hipSuccess) { fprintf(stderr, "memset failed\n"); return; }
    P p{};
    for (int i = 0; i < 29; ++i) p.in[i] = (const float*)d_in[i];
    p.out = (float*)d_out; p.ws = (unsigned char*)d_ws;
#if N_LAUNCH_MODE == 1
    p.ph_lo = 0; p.ph_hi = N_PHASES;
    void* args[] = {&p};
    hipError_t e = hipLaunchCooperativeKernel((const void*)mega, dim3(grid_blocks), dim3(NT), args, LDS_BYTES, stream);
    if (e != hipSuccess) fprintf(stderr, "cooperative launch failed: %s (grid %d)\n", hipGetErrorString(e), grid_blocks);
#else
    for (int ph = 0; ph < N_PHASES; ++ph) {
        if (ph > 0 && ph < N_PHASES - 1 && (ph - 1) / PPL == 1 && ((ph - 1) % PPL >= 6 && (ph - 1) % PPL <= 8)) continue;
        p.ph_lo = ph; p.ph_hi = ph + 1;
        hipLaunchKernelGGL(mega, dim3(grid_blocks), dim3(NT), LDS_BYTES, stream, p);
    }
#endif
}
```

```cpp
#include <hip/hip_runtime.h>
#include <hip/hip_cooperative_groups.h>
#include <cstdio>
#include <cstdint>
namespace cg = cooperative_groups;

#ifndef PROBE
#define PROBE 0
#endif
#ifndef N_LAUNCH_MODE
#define N_LAUNCH_MODE 1
#endif

typedef unsigned short bf16;
typedef short bf16x8 __attribute__((ext_vector_type(8)));
typedef float f32x4 __attribute__((ext_vector_type(4)));
typedef unsigned u32x4 __attribute__((ext_vector_type(4)));
typedef unsigned u32x2 __attribute__((ext_vector_type(2)));

#define NT 512
#define NWV 8
#define LDS_BYTES 147456

constexpr size_t WS_X = 0;
constexpr size_t WS_HN = WS_X + 33554432;
constexpr size_t WS_MOD = WS_HN + 16777216;
constexpr size_t WS_CK = WS_MOD + 221184;
constexpr size_t WS_CVT = WS_CK + 1048576;
constexpr size_t WS_W = WS_CVT + 1048576;
constexpr size_t W_GU0 = 0, W_D0 = 11534336, W_IN = 17301504, W_GU1 = 25165824, W_D1 = 36700160, W_OUT = 42467328, W_TOTAL = 44564480;
constexpr size_t W_CST = 0;
constexpr size_t WS_R = WS_W + W_TOTAL;
constexpr size_t R_ACT = 0;
constexpr size_t R_PROJ = 0, R_GATES = 59244544, R_HM = 60293120, R_HD = 77070336, R_D1 = 93847552, R_KV = 169607168, R_MS = 203423744, R_END = 203440128;
constexpr size_t R_PART = 67108864;
constexpr size_t R_Q = 0, R_K = 16777216, R_VT = 33554432;
constexpr size_t WS_BAR = WS_R + R_END;
constexpr size_t WS_END = WS_BAR + 16384;
constexpr int REC = 73984;

struct P { const float* in[29]; float* out; unsigned char* ws; int ph_lo, ph_hi, tid, bid; };

constexpr size_t O_YP = 0, O_YS = 4194304, O_C = 8388608, O_N = O_C + 1048576, O_M = O_N + 8192, O_S = O_M + 128, O_K = O_S + 2097152, O_V = O_K + 4194304;

__device__ __forceinline__ unsigned pk2(float a, float b) { unsigned r; asm("s_nop 1\n\tv_cvt_pk_bf16_f32 %0, %1, %2" : "=v"(r) : "v"(a), "v"(b)); return r; }
__device__ __forceinline__ bf16 f2b(float f) { return (bf16)(pk2(f, f) & 0xffffu); }
__device__ __forceinline__ float b2f(bf16 b) { return __uint_as_float(((unsigned)b) << 16); }

__device__ __forceinline__ float silu_f(float x) { return x * __builtin_amdgcn_rcpf(1.f + __expf(-x)); }
__device__ __forceinline__ float sigm_f(float x) { return __builtin_amdgcn_rcpf(1.f + __expf(-x)); }
__device__ __forceinline__ float softplus_f(float x) { return fmaxf(x, 0.f) + __logf(1.f + __expf(-fabsf(x))); }
__device__ __forceinline__ int grp_of(int row) { return row < 4096 ? 0 : 1 + ((row - 4096) >> 11); }
__device__ __forceinline__ uint4 ld_nt16(const void* p) { const u32x4 t = __builtin_nontemporal_load((const u32x4*)p); return make_uint4(t[0], t[1], t[2], t[3]); }
__device__ __forceinline__ void lds_barrier() { asm volatile("s_waitcnt lgkmcnt(0)\n\ts_barrier" ::: "memory"); }
template <int CTRL> __device__ __forceinline__ float dppf(float x) { return __builtin_bit_cast(float, __builtin_amdgcn_update_dpp(0, __builtin_bit_cast(int, x), CTRL, 0xF, 0xF, true)); }
__device__ __forceinline__ float row16_max(float x) { x = fmaxf(x, dppf<0x128>(x)); x = fmaxf(x, dppf<0x124>(x)); x = fmaxf(x, dppf<0x122>(x)); return fmaxf(x, dppf<0x121>(x)); }
__device__ __forceinline__ float row16_sum(float x) { x += dppf<0x128>(x); x += dppf<0x124>(x); x += dppf<0x122>(x); return x + dppf<0x121>(x); }
__device__ __forceinline__ f32x4 mfma16(bf16x8 a, bf16x8 b, f32x4 c) { return __builtin_amdgcn_mfma_f32_16x16x32_bf16(a, b, c, 0, 0, 0); }

template <int M, int N, int K, class F>
__device__ __forceinline__ void mm(int tid_, const bf16* A, int lda, const bf16* B, int ldb, F&& f) {
    const int lane = tid_ & 63, wave = tid_ >> 6, r = lane & 15, q = lane >> 4;
    constexpr int TN = N / 16, NTL = (M / 16) * TN, ITERS = (NTL + NWV - 1) / NWV;
#pragma unroll
    for (int it = 0; it < ITERS; ++it) {
        const int t = wave + it * NWV;
        if (t < NTL) {
            const int tm = t / TN, tn = t % TN;
            f32x4 acc = {0.f, 0.f, 0.f, 0.f};
#pragma unroll
            for (int k = 0; k < K; k += 32) {
                bf16x8 a = *(const bf16x8*)(A + (tm * 16 + r) * lda + k + q * 8);
                bf16x8 b = *(const bf16x8*)(B + (tn * 16 + r) * ldb + k + q * 8);
                acc = mfma16(a, b, acc);
            }
#pragma unroll
            for (int e = 0; e < 4; ++e) f(it, e, tm * 16 + q * 4 + e, tn * 16 + r, acc[e]);
        }
    }
}

namespace pg8 {
#define PG8_LAS __attribute__((address_space(3)))
typedef unsigned short bf16_t;
typedef short bf16x8 __attribute__((ext_vector_type(8)));
typedef float f32x4 __attribute__((ext_vector_type(4)));
constexpr int BM = 256, BK = 64, HALF = 128, HTB = HALF * BK * 2, STAGE_BYTES = 8 * HTB, NXCD = 8, WGM = 8;
__host__ __device__ __forceinline__ int lds_byte(int r, int c) { const int st = (r >> 4) * 2 + (c >> 5), rr = r & 15, cc = c & 31, ob = rr * 64 + cc * 2; return st * 1024 + (ob ^ (((ob >> 9) & 1) << 5)); }
__host__ __device__ __forceinline__ void stage_rc(int b, int& R, int& C) { const int st = b / 1024, sb = b % 1024, swz = sb ^ (((sb >> 9) & 1) << 5); R = (st >> 1) * 16 + swz / 64; C = (st & 1) * 32 + (swz % 64) / 2; }
__host__ __device__ __forceinline__ int perm32(int rho) { const int n = rho >> 4, i = rho & 15; return 8 * (i >> 2) + 4 * n + (i & 3); }
struct Unit { int pm, pn, ko; };
struct Gemm { const bf16_t* A; const bf16_t* Bt; int ld, K; };
struct StaticOrder {
    int nM, nN, nwg, G, c;
    __device__ void init(int M, int N, int G_, int c_) { nM = M / BM; nN = N / BM; nwg = nM * nN; G = G_; c = c_; }
    __device__ bool next(int i, Unit& u) const {
        const long L = (long)i * G + c; if (L >= nwg) return false;
        int wgid = (int)L; { const int q = nwg / NXCD, r = nwg % NXCD, xcd = wgid % NXCD, off = wgid / NXCD; wgid = (xcd < r ? xcd * (q + 1) : r * (q + 1) + (xcd - r) * q) + off; }
        const int nig = WGM * nN, gid = wgid / nig, fm = gid * WGM, gsz = (nM - fm) < WGM ? (nM - fm) : WGM;
        u.pm = fm + ((wgid % nig) % gsz); u.pn = (wgid % nig) / gsz; u.ko = 0; return true;
    }
    __device__ __forceinline__ void a_ready(const Unit&) const {}
    __device__ __forceinline__ void done(const Unit&) const {}
};
struct SplitK2Order {
    int c, G, kbytes;
    __device__ bool next(int i, Unit& u) const {
        const int L = i * G + c; if (L >= 256) return false;
        const int x = L & 7, o = L >> 3; u.pm = 4 * x + (o & 3); u.pn = (o >> 2) & 3; u.ko = (o >> 4) * kbytes; return true;
    }
    __device__ __forceinline__ void a_ready(const Unit&) const {}
    __device__ __forceinline__ void done(const Unit&) const {}
};
template <class Epi, class Sched, bool ALIGN_EPI = false, bool SP2 = false>
__device__ __forceinline__ void gemm_phase(PG8_LAS unsigned char* lds, const Gemm g, const Sched& S, const Epi& E, int tid_in) {
    const int tid = tid_in, wid = __builtin_amdgcn_readfirstlane(tid >> 6), lane = tid & 63, wr = wid >> 2, wc = wid & 3, fr = lane & 15, fq = lane >> 4;
    const int K = g.ld, nt = g.K / BK;
    unsigned voffA[2], voffB[2];
#pragma unroll
    for (int i = 0; i < 2; ++i) { int R, C; stage_rc(tid * 16 + i * 8192, R, C); const int Rb = Epi::PERM ? ((R & ~31) + perm32(R & 31)) : R;
        voffA[i] = (unsigned)(R * K + C) * 2u; voffB[i] = (unsigned)(Rb * K + C) * 2u; }
    const size_t kstep = (size_t)(BK * 2);
    const size_t hstep = (size_t)HALF * K * 2;
    const size_t tstep = 2 * hstep;
    const unsigned ldsw = (unsigned)wid * 1024u;
    const int aoff = lds_byte(wr * 64 + fr, fq * 8), boff = lds_byte(wc * 32 + fr, fq * 8);
#define PG8_SA(b, h) (((b) * 2 + (h)) * HTB)
#define PG8_SB(b, h) ((4 + (b) * 2 + (h)) * HTB)
#define PG8_STAGE(bufoff, gbase, voff) do { _Pragma("unroll") for (int _i = 0; _i < 2; ++_i) \
        __builtin_amdgcn_global_load_lds((const unsigned*)((const char*)(gbase) + (voff)[_i]), (PG8_LAS unsigned*)(lds + (bufoff) + ldsw + _i * 8192), 16, 0, 0); } while (0)
#define PG8_LDA(dst, b, h) do { _Pragma("unroll") for (int m = 0; m < 4; ++m) _Pragma("unroll") for (int k = 0; k < 2; ++k) dst[m][k] = *(const PG8_LAS bf16x8*)(lds + PG8_SA(b, h) + aoff + m * 2048 + k * 1024); } while (0)
#define PG8_LDB(dst, b, h) do { _Pragma("unroll") for (int n = 0; n < 2; ++n) _Pragma("unroll") for (int k = 0; k < 2; ++k) dst[n][k] = *(const PG8_LAS bf16x8*)(lds + PG8_SB(b, h) + boff + n * 2048 + k * 1024); } while (0)
#define PG8_MMA(ai, bj, At, Bt) do { __builtin_amdgcn_s_setprio(1); _Pragma("unroll") for (int m = 0; m < 4; ++m) _Pragma("unroll") for (int n = 0; n < 2; ++n) _Pragma("unroll") for (int k = 0; k < 2; ++k) \
        acc[ai][bj][m][n] = __builtin_amdgcn_mfma_f32_16x16x32_bf16(Bt[n][k], At[m][k], acc[ai][bj][m][n], 0, 0, 0); __builtin_amdgcn_s_setprio(0); } while (0)
#define PG8_WAIT_V(n) asm volatile("s_waitcnt vmcnt(" #n ")" ::: "memory")
#define PG8_WAIT_L(n) asm volatile("s_waitcnt lgkmcnt(" #n ")" ::: "memory")
#define PG8_BAR __builtin_amdgcn_s_barrier()
#define PG8_SCHED __builtin_amdgcn_sched_barrier(0)
    Unit cur, nxt; int ui = 0;
    if (!S.next(0, cur)) return;
    f32x4 acc[2][2][4][2];
#pragma unroll
    for (int a = 0; a < 2; ++a)
#pragma unroll
        for (int b = 0; b < 2; ++b)
#pragma unroll
            for (int m = 0; m < 4; ++m)
#pragma unroll
                for (int n = 0; n < 2; ++n) acc[a][b][m][n] = (f32x4){0.f, 0.f, 0.f, 0.f};
    bf16x8 At[4][2], B0[2][2], B1[2][2];
    const char* cA = (const char*)g.A + (size_t)cur.pm * tstep + cur.ko; const char* cB = (const char*)g.Bt + (size_t)cur.pn * tstep + cur.ko;
    S.a_ready(cur);
    if constexpr (SP2) {
        PG8_STAGE(PG8_SB(0, 0), cB, voffB); PG8_STAGE(PG8_SB(0, 1), cB + hstep, voffB); PG8_STAGE(PG8_SA(0, 0), cA, voffA); PG8_STAGE(PG8_SA(0, 1), cA + hstep, voffA);
        if (wr == 1) PG8_BAR;
        PG8_WAIT_V(2); PG8_BAR;
        PG8_STAGE(PG8_SB(1, 0), cB + kstep, voffB); PG8_STAGE(PG8_SA(1, 0), cA + kstep, voffA); PG8_STAGE(PG8_SB(1, 1), cB + hstep + kstep, voffB);
        PG8_WAIT_V(6); PG8_BAR;
    } else {
        PG8_STAGE(PG8_SB(0, 0), cB, voffB); PG8_STAGE(PG8_SA(0, 0), cA, voffA); PG8_STAGE(PG8_SB(0, 1), cB + hstep, voffB); PG8_STAGE(PG8_SA(0, 1), cA + hstep, voffA);
        if (wr == 1) PG8_BAR;
        PG8_WAIT_V(4); PG8_BAR;
        PG8_STAGE(PG8_SB(1, 0), cB + kstep, voffB); PG8_STAGE(PG8_SA(1, 0), cA + kstep, voffA); PG8_STAGE(PG8_SB(1, 1), cB + hstep + kstep, voffB);
        PG8_WAIT_V(6); PG8_BAR;
    }
    for (;;) {
        const bool has_next = S.next(ui + 1, nxt);
        const char* nA = has_next ? (const char*)g.A + (size_t)nxt.pm * tstep + nxt.ko : cA; const char* nB = has_next ? (const char*)g.Bt + (size_t)nxt.pn * tstep + nxt.ko : cB;
        for (int t = 0; t < nt; t += 2) {
            const bool last = (t == nt - 2);
            const char* a1 = cA + (size_t)(t + 1) * kstep;
            const char* a2 = last ? nA : cA + (size_t)(t + 2) * kstep; const char* b2 = last ? nB : cB + (size_t)(t + 2) * kstep;
            const char* a3 = a2 + kstep; const char* b3 = b2 + kstep;
            if (last && has_next) S.a_ready(nxt);
            if constexpr (SP2) {
            PG8_LDB(B0, 0, 0); PG8_LDB(B1, 0, 1); PG8_SCHED; PG8_LDA(At, 0, 0); PG8_STAGE(PG8_SA(1, 1), a1 + hstep, voffA);
            PG8_WAIT_V(8); PG8_WAIT_L(0); PG8_BAR; PG8_MMA(0, 0, At, B0); PG8_MMA(0, 1, At, B1); PG8_BAR; PG8_SCHED;
            PG8_LDA(At, 0, 1); PG8_STAGE(PG8_SB(0, 0), b2, voffB); PG8_STAGE(PG8_SB(0, 1), b2 + hstep, voffB); PG8_STAGE(PG8_SA(0, 0), a2, voffA);
            PG8_WAIT_V(8); PG8_WAIT_L(0); PG8_BAR; PG8_MMA(1, 0, At, B0); PG8_MMA(1, 1, At, B1); PG8_BAR; PG8_SCHED;
            PG8_LDB(B0, 1, 0); PG8_LDB(B1, 1, 1); PG8_SCHED; PG8_LDA(At, 1, 0); PG8_STAGE(PG8_SA(0, 1), a2 + hstep, voffA);
            PG8_WAIT_V(8); PG8_WAIT_L(0); PG8_BAR; PG8_MMA(0, 0, At, B0); PG8_MMA(0, 1, At, B1); PG8_BAR; PG8_SCHED;
            PG8_LDA(At, 1, 1); PG8_STAGE(PG8_SB(1, 0), b3, voffB); PG8_STAGE(PG8_SB(1, 1), b3 + hstep, voffB); PG8_STAGE(PG8_SA(1, 0), a3, voffA);
            PG8_WAIT_V(8); PG8_WAIT_L(0); PG8_BAR; PG8_MMA(1, 0, At, B0); PG8_MMA(1, 1, At, B1); PG8_BAR; PG8_SCHED;
            } else {
            PG8_LDB(B0, 0, 0); PG8_SCHED; PG8_LDA(At, 0, 0); PG8_STAGE(PG8_SA(1, 1), a1 + hstep, voffA);
            PG8_WAIT_L(8); PG8_BAR; PG8_WAIT_L(0); PG8_MMA(0, 0, At, B0); PG8_BAR; PG8_SCHED;
            PG8_LDB(B1, 0, 1); PG8_STAGE(PG8_SB(0, 0), b2, voffB);
            PG8_BAR; PG8_WAIT_L(0); PG8_MMA(0, 1, At, B1); PG8_BAR;
            PG8_LDA(At, 0, 1); PG8_STAGE(PG8_SA(0, 0), a2, voffA);
            PG8_BAR; PG8_WAIT_L(0); PG8_MMA(1, 0, At, B0); PG8_BAR; PG8_SCHED;
            PG8_STAGE(PG8_SB(0, 1), b2 + hstep, voffB);
            PG8_WAIT_V(6); PG8_BAR; PG8_MMA(1, 1, At, B1); PG8_BAR;
            PG8_LDB(B0, 1, 0); PG8_SCHED; PG8_LDA(At, 1, 0); PG8_STAGE(PG8_SA(0, 1), a2 + hstep, voffA);
            PG8_WAIT_L(8); PG8_BAR; PG8_WAIT_L(0); PG8_MMA(0, 0, At, B0); PG8_BAR; PG8_SCHED;
            PG8_LDB(B1, 1, 1); PG8_STAGE(PG8_SB(1, 0), b3, voffB);
            PG8_BAR; PG8_WAIT_L(0); PG8_MMA(0, 1, At, B1); PG8_BAR;
            PG8_LDA(At, 1, 1); PG8_STAGE(PG8_SA(1, 0), a3, voffA);
            PG8_BAR; PG8_WAIT_L(0); PG8_MMA(1, 0, At, B0); PG8_BAR; PG8_SCHED;
            PG8_STAGE(PG8_SB(1, 1), b3 + hstep, voffB);
            PG8_WAIT_V(6); PG8_BAR; PG8_MMA(1, 1, At, B1); PG8_BAR;
            }
        }
        if constexpr (ALIGN_EPI) { if (wr == 0) PG8_BAR; }
        if constexpr (!Epi::AFTER_DRAIN) { E(acc, cur, wr, wc, fr, fq); S.done(cur); }
        if (!has_next) break;
#pragma unroll
        for (int a = 0; a < 2; ++a)
#pragma unroll
            for (int b = 0; b < 2; ++b)
#pragma unroll
                for (int m = 0; m < 4; ++m)
#pragma unroll
                    for (int n = 0; n < 2; ++n) acc[a][b][m][n] = (f32x4){0.f, 0.f, 0.f, 0.f};
        cur = nxt; cA = nA; cB = nB; ++ui;
        if constexpr (ALIGN_EPI) { if (wr == 1) PG8_BAR; }
    }
    PG8_WAIT_V(0);
    if constexpr (!ALIGN_EPI) { if (wr == 0) PG8_BAR; }
    PG8_BAR;
    if constexpr (Epi::AFTER_DRAIN) { E.fused(acc, cur, wr, wc, fr, fq, lds, wid, lane); S.done(cur); }
#undef PG8_SA
#undef PG8_SB
#undef PG8_STAGE
#undef PG8_LDA
#undef PG8_LDB
#undef PG8_MMA
#undef PG8_WAIT_V
#undef PG8_WAIT_L
#undef PG8_BAR
#undef PG8_SCHED
}
}

struct EpGU {
    static constexpr bool PERM = true, AFTER_DRAIN = false; bf16* act;
    __device__ __forceinline__ void operator()(const f32x4 (&acc)[2][2][4][2], const pg8::Unit& u, int wr, int wc, int fr, int fq) const {
        const int f0 = u.pn * 128 + wc * 32 + fq * 8;
#pragma unroll
        for (int ai = 0; ai < 2; ++ai)
#pragma unroll
            for (int m = 0; m < 4; ++m) {
                const int row = u.pm * 256 + ai * 128 + wr * 64 + m * 16 + fr;
                const f32x4 g0 = acc[ai][0][m][0], g1 = acc[ai][0][m][1], u0 = acc[ai][1][m][0], u1 = acc[ai][1][m][1];
                uint4 o;
                o.x = pk2(silu_f(g0[0]) * u0[0], silu_f(g0[1]) * u0[1]); o.y = pk2(silu_f(g0[2]) * u0[2], silu_f(g0[3]) * u0[3]);
                o.z = pk2(silu_f(g1[0]) * u1[0], silu_f(g1[1]) * u1[1]); o.w = pk2(silu_f(g1[2]) * u1[2], silu_f(g1[3]) * u1[3]);
                *(uint4*)(act + (size_t)row * 2816 + f0) = o;
            }
    }
};
struct EpPart {
    static constexpr bool PERM = true, AFTER_DRAIN = false; bf16* part;
    __device__ __forceinline__ void operator()(const f32x4 (&acc)[2][2][4][2], const pg8::Unit& u, int wr, int wc, int fr, int fq) const {
        bf16* base = part + (u.ko ? 8388608 : 0);
#pragma unroll
        for (int ai = 0; ai < 2; ++ai)
#pragma unroll
            for (int m = 0; m < 4; ++m) {
                const int row = u.pm * 256 + ai * 128 + wr * 64 + m * 16 + fr;
#pragma unroll
                for (int bj = 0; bj < 2; ++bj) {
                    const f32x4 v0 = acc[ai][bj][m][0], v1 = acc[ai][bj][m][1];
                    uint4 o; o.x = pk2(v0[0], v0[1]); o.y = pk2(v0[2], v0[3]); o.z = pk2(v1[0], v1[1]); o.w = pk2(v1[2], v1[3]);
                    *(uint4*)(base + (size_t)row * 1024 + u.pn * 256 + bj * 128 + wc * 32 + fq * 8) = o;
                }
            }
    }
};
struct EpIn0 {
    static constexpr bool PERM = true, AFTER_DRAIN = false; bf16* proj; float* gates;
    __device__ __forceinline__ void operator()(const f32x4 (&acc)[2][2][4][2], const pg8::Unit& u, int wr, int wc, int fr, int fq) const {
#pragma unroll
        for (int bj = 0; bj < 2; ++bj) {
            const int c0 = u.pn * 256 + bj * 128 + wc * 32 + fq * 8;
            if (c0 < 3616) {
                int gi = -1;
                if (c0 >= 1536 && c0 < 1552) gi = c0 - 1536; else if (c0 >= 3600) gi = 16 + c0 - 3600;
#pragma unroll
                for (int ai = 0; ai < 2; ++ai)
#pragma unroll
                    for (int m = 0; m < 4; ++m) {
                        const int row = u.pm * 256 + ai * 128 + wr * 64 + m * 16 + fr;
                        const f32x4 v0 = acc[ai][bj][m][0], v1 = acc[ai][bj][m][1];
                        uint4 o; o.x = pk2(v0[0], v0[1]); o.y = pk2(v0[2], v0[3]); o.z = pk2(v1[0], v1[1]); o.w = pk2(v1[2], v1[3]);
                        *(uint4*)(proj + (size_t)row * 3616 + c0) = o;
                        if (gi >= 0) { *(f32x4*)(gates + row * 32 + gi) = v0; *(f32x4*)(gates + row * 32 + gi + 4) = v1; }
                    }
            }
        }
    }
};
struct EpIn1 {
    static constexpr bool PERM = true, AFTER_DRAIN = false; bf16* Q; bf16* Kb; bf16* VT; float* outk; float* outv;
    __device__ __forceinline__ void operator()(const f32x4 (&acc)[2][2][4][2], const pg8::Unit& u, int wr, int wc, int fr, int fq) const {
#pragma unroll
        for (int bj = 0; bj < 2; ++bj) {
            const int c0 = u.pn * 256 + bj * 128 + wc * 32 + fq * 8, sec = c0 >> 10, c2 = c0 & 1023, h = c2 >> 6, d0 = c2 & 63;
#pragma unroll
            for (int ai = 0; ai < 2; ++ai)
#pragma unroll
                for (int m = 0; m < 4; ++m) {
                    const int row = u.pm * 256 + ai * 128 + wr * 64 + m * 16 + fr;
                    const f32x4 v0 = acc[ai][bj][m][0], v1 = acc[ai][bj][m][1];
                    if (sec == 0) {
                        uint4 o; o.x = pk2(v0[0] * 0.125f, v0[1] * 0.125f); o.y = pk2(v0[2] * 0.125f, v0[3] * 0.125f); o.z = pk2(v1[0] * 0.125f, v1[1] * 0.125f); o.w = pk2(v1[2] * 0.125f, v1[3] * 0.125f);
                        *(uint4*)(Q + (size_t)row * 1024 + c2) = o;
                    } else if (sec == 1) {
                        uint4 o; o.x = pk2(v0[0], v0[1]); o.y = pk2(v0[2], v0[3]); o.z = pk2(v1[0], v1[1]); o.w = pk2(v1[2], v1[3]);
                        *(uint4*)(Kb + (size_t)row * 1024 + c2) = o;
                        if (row < 4096) { float* ok = outk + ((size_t)((row >> 8) * 16 + h) * 256 + (row & 255)) * 64 + d0; __builtin_nontemporal_store(v0, (f32x4*)ok); __builtin_nontemporal_store(v1, (f32x4*)(ok + 4)); }
                    } else {
                        if (row < 4096) {
                            const int b = row >> 8, t = row & 255;
                            bf16* vp = VT + ((size_t)(b * 16 + h) * 64 + d0) * 256 + t;
#pragma unroll
                            for (int jj = 0; jj < 4; ++jj) { vp[jj * 256] = f2b(v0[jj]); vp[(jj + 4) * 256] = f2b(v1[jj]); }
                            float* ov = outv + ((size_t)(b * 16 + h) * 256 + t) * 64 + d0; __builtin_nontemporal_store(v0, (f32x4*)ov); __builtin_nontemporal_store(v1, (f32x4*)(ov + 4));
                        } else {
                            const int r2 = row - 4096, b = r2 >> 11, t = r2 & 2047;
                            bf16* vp = VT + 4194304 + ((size_t)(b * 16 + h) * 64 + d0) * 2048 + t;
#pragma unroll
                            for (int jj = 0; jj < 4; ++jj) { vp[jj * 2048] = f2b(v0[jj]); vp[(jj + 4) * 2048] = f2b(v1[jj]); }
                        }
                    }
                }
        }
    }
};

__device__ __forceinline__ void adaln_tile(const P& p, unsigned char* smem, int tile) {
    float* sc = (float*)smem; float* red = sc + 3072;
    const int tid = p.tid;
    const float* cctx = p.in[9]; const float* cc = p.in[2];
    for (int i = tid; i < 3072; i += NT) { const int g = i >> 10, k = i & 1023; const float v = (g == 0) ? cctx[k] : cc[(g - 1) * 1024 + k]; sc[i] = silu_f(v); }
    __syncthreads();
    const int l = tile / 144, col0 = (tile % 144) * 64, cl = tid & 15, kg = tid >> 4;
    const float* W = p.in[10] + (size_t)l * 1024 * 9216 + col0 + cl * 4;
    float a0[4] = {0, 0, 0, 0}, a1[4] = {0, 0, 0, 0}, a2[4] = {0, 0, 0, 0};
    for (int k = kg; k < 1024; k += 32) {
        const f32x4 w4_ = __builtin_nontemporal_load((const f32x4*)(W + (size_t)k * 9216)); const float4 w = make_float4(w4_[0], w4_[1], w4_[2], w4_[3]);
        const float s0 = sc[k], s1 = sc[1024 + k], s2 = sc[2048 + k];
        a0[0] += s0 * w.x; a0[1] += s0 * w.y; a0[2] += s0 * w.z; a0[3] += s0 * w.w;
        a1[0] += s1 * w.x; a1[1] += s1 * w.y; a1[2] += s1 * w.z; a1[3] += s1 * w.w;
        a2[0] += s2 * w.x; a2[1] += s2 * w.y; a2[2] += s2 * w.z; a2[3] += s2 * w.w;
    }
#pragma unroll
    for (int j = 0; j < 4; ++j) { red[(kg * 3 + 0) * 64 + cl * 4 + j] = a0[j]; red[(kg * 3 + 1) * 64 + cl * 4 + j] = a1[j]; red[(kg * 3 + 2) * 64 + cl * 4 + j] = a2[j]; }
    __syncthreads();
    if (tid < 192) {
        const int g = tid >> 6, c = tid & 63; float s = 0.f;
        for (int k2 = 0; k2 < 32; ++k2) s += red[(k2 * 3 + g) * 64 + c];
        float* MOD = (float*)(p.ws + WS_MOD);
        MOD[(l * 3 + g) * 9216 + col0 + c] = s + p.in[11][l * 9216 + col0 + c];
    }
    __syncthreads();
}

__device__ __forceinline__ void conv_tile(const float* src, int srcld, bf16* dst, int dstld, int N, int mode, int tk, int tn, unsigned char* smem, int tid) {
    float* t = (float*)smem;
    const int k0 = tk * 128, n0 = tn * 128;
    float4 v[8];
#pragma unroll
    for (int u = 0; u < 8; ++u) {
        const int i = tid + u * NT, kk = i >> 5, n = n0 + (i & 31) * 4;
        v[u] = (float4){0.f, 0.f, 0.f, 0.f};
        if (n < N) { const f32x4 t4 = __builtin_nontemporal_load((const f32x4*)(src + (size_t)(k0 + kk) * srcld + n)); v[u] = make_float4(t4[0], t4[1], t4[2], t4[3]); }
    }
#pragma unroll
    for (int u = 0; u < 8; ++u) {
        const int i = tid + u * NT, kk = i >> 5, n4 = (i & 31) * 4;
        t[kk * 129 + n4] = v[u].x; t[kk * 129 + n4 + 1] = v[u].y; t[kk * 129 + n4 + 2] = v[u].z; t[kk * 129 + n4 + 3] = v[u].w;
    }
    __syncthreads();
    const int nl = tid >> 2, q4 = tid & 3, n = n0 + nl;
    const int row = mode == 0 ? n : (n / 128) * 256 + (n % 128) + (mode == 2 ? 128 : 0);
#pragma unroll
    for (int m = 0; m < 4; ++m) {
        const int kb = q4 * 8 + 32 * m;
        uint4 o;
        o.x = pk2(t[(kb + 0) * 129 + nl], t[(kb + 1) * 129 + nl]); o.y = pk2(t[(kb + 2) * 129 + nl], t[(kb + 3) * 129 + nl]);
        o.z = pk2(t[(kb + 4) * 129 + nl], t[(kb + 5) * 129 + nl]); o.w = pk2(t[(kb + 6) * 129 + nl], t[(kb + 7) * 129 + nl]);
        *(uint4*)(dst + (size_t)row * dstld + k0 + kb) = o;
    }
    __syncthreads();
}
__device__ __forceinline__ int conv_count(int l) { return 4 * 176 + 2 * 176 + 8 * (l == 0 ? 29 : 24) + 64; }
__device__ __forceinline__ void conv_weights_tile(const P& p, unsigned char* smem, int l, int idx) {
    unsigned char* W = p.ws + WS_W;
    const float* src; bf16* dst; int srcld, dstld, N, mode, tk, tn;
    const float* in13 = p.in[13]; const float* in14 = p.in[14]; const float* in16 = p.in[16]; const float* in25 = p.in[25]; const float* in17 = p.in[17]; const float* in26 = p.in[26];
    asm volatile("" : "+s"(in13), "+s"(in14), "+s"(in16), "+s"(in25), "+s"(in17), "+s"(in26));
    if (idx < 4 * 176) {
        const int f = idx / 352, which = (idx / 176) & 1, t = idx % 176; tk = t / 22; tn = t % 22;
        src = (which ? in14 : in13) + (size_t)(l * 2 + f) * 1024 * 2816; srcld = 2816; dst = (bf16*)(W + (f ? W_GU1 : W_GU0)); dstld = 1024; N = 2816; mode = 1 + which;
    } else if (idx < 6 * 176) {
        const int i2 = idx - 4 * 176, f = i2 / 176, t = i2 % 176; tk = t / 8; tn = t % 8;
        src = p.in[15] + (size_t)(l * 2 + f) * 2816 * 1024; srcld = 1024; dst = (bf16*)(W + (f ? W_D1 : W_D0)); dstld = 2816; N = 1024; mode = 0;
    } else {
        const int nin = (l == 0 ? 29 : 24);
        int i2 = idx - 6 * 176;
        if (i2 < 8 * nin) { tk = i2 / nin; tn = i2 % nin; src = l == 0 ? in16 : in25; srcld = N = (l == 0 ? 3616 : 3072); dst = (bf16*)(W + W_IN); dstld = 1024; mode = 0; }
        else { i2 -= 8 * nin; tk = i2 / 8; tn = i2 % 8; src = l == 0 ? in17 : in26; srcld = N = 1024; dst = (bf16*)(W + W_OUT); dstld = 1024; mode = 0; }
    }
    conv_tile(src, srcld, dst, dstld, N, mode, tk, tn, smem, p.tid);
}

__device__ __forceinline__ void ph_prologue(const P& p, unsigned char* smem) {
    for (int t = p.bid; t < 288; t += gridDim.x) adaln_tile(p, smem, t);
    bf16* CK = (bf16*)(p.ws + WS_CK); bf16* CVT = (bf16*)(p.ws + WS_CVT);
    for (int i = p.bid * NT + p.tid; i < 524288; i += gridDim.x * NT) {
        CK[i] = f2b(p.in[7][i]);
        const int d = i & 63, key = (i >> 6) & 255, bh = i >> 14;
        CVT[(bh * 64 + d) * 256 + key] = f2b(p.in[8][i]);
    }
}

__device__ __forceinline__ void ph_norm(const P& p, int l, int j, bool has_res, int resl, int resgi, float coef, bool fin, int rbase, int rend, int rstride, bool x_in) {
    const int lane = p.tid & 63, wave = p.tid >> 6;
    float* X = (float*)(p.ws + WS_X); bf16* HN = (bf16*)(p.ws + WS_HN);
    const float* MOD = (const float*)(p.ws + WS_MOD);
    const bf16* P0 = (const bf16*)(p.ws + WS_R + R_PART); const bf16* P1 = P0 + 8388608;
    const float* g = fin ? p.in[28] : p.in[12] + (l * 3 + j) * 1024;
    float4 v[4][4]; uint2 pa[4][4], pb[4][4];
#pragma unroll
    for (int k = 0; k < 4; ++k) {
        const int row = min(rbase + wave + k * rstride, 8191);
        const float* xs = x_in ? (row < 4096 ? p.in[0] + (size_t)row * 1024 : p.in[1] + (size_t)(row - 4096) * 1024) : X + (size_t)row * 1024;
#pragma unroll
        for (int i = 0; i < 4; ++i) {
            const int c = i * 256 + lane * 4;
            { const f32x4 t4 = __builtin_nontemporal_load((const f32x4*)(xs + c)); v[k][i] = make_float4(t4[0], t4[1], t4[2], t4[3]); }
            if (has_res) { const u32x2 ta = __builtin_nontemporal_load((const u32x2*)(P0 + (size_t)row * 1024 + c)), tb = __builtin_nontemporal_load((const u32x2*)(P1 + (size_t)row * 1024 + c)); pa[k][i] = make_uint2(ta[0], ta[1]); pb[k][i] = make_uint2(tb[0], tb[1]); }
        }
    }
#pragma unroll
    for (int k = 0; k < 4; ++k) {
        const int row = rbase + wave + k * rstride;
        if (row < rend) {
            const int grp = grp_of(row);
            float ss = 0.f;
#pragma unroll
            for (int i = 0; i < 4; ++i) {
                const int c = i * 256 + lane * 4;
                if (has_res) {
                    const uint2 a = pa[k][i], b = pb[k][i];
                    const float4 mg = *(const float4*)(MOD + (resl * 3 + grp) * 9216 + resgi * 1024 + c);
                    v[k][i].x += coef * mg.x * (b2f((bf16)(a.x & 0xffff)) + b2f((bf16)(b.x & 0xffff))); v[k][i].y += coef * mg.y * (b2f((bf16)(a.x >> 16)) + b2f((bf16)(b.x >> 16)));
                    v[k][i].z += coef * mg.z * (b2f((bf16)(a.y & 0xffff)) + b2f((bf16)(b.y & 0xffff))); v[k][i].w += coef * mg.w * (b2f((bf16)(a.y >> 16)) + b2f((bf16)(b.y >> 16)));
                    if (!fin) *(float4*)(X + (size_t)row * 1024 + c) = v[k][i];
                }
                ss += v[k][i].x * v[k][i].x + v[k][i].y * v[k][i].y + v[k][i].z * v[k][i].z + v[k][i].w * v[k][i].w;
            }
#pragma unroll
            for (int o = 32; o >= 1; o >>= 1) ss += __shfl_xor(ss, o);
            const float rs = rsqrtf(ss * (1.f / 1024.f) + 1e-6f);
            if (fin) {
#pragma unroll
                for (int i = 0; i < 4; ++i) {
                    const int c = i * 256 + lane * 4; const float4 gg = *(const float4*)(g + c);
                    float4 o = {v[k][i].x * rs * gg.x, v[k][i].y * rs * gg.y, v[k][i].z * rs * gg.z, v[k][i].w * rs * gg.w};
                    __builtin_nontemporal_store((f32x4){o.x, o.y, o.z, o.w}, (f32x4*)(p.out + (size_t)row * 1024 + c));
                }
            } else {
                const float* mod = MOD + (l * 3 + grp) * 9216;
                const float* sh = mod + (3 * j) * 1024; const float* sc = mod + (3 * j + 1) * 1024;
#pragma unroll
                for (int i = 0; i < 4; ++i) {
                    const int c = i * 256 + lane * 4;
                    const float4 gg = *(const float4*)(g + c), s4 = *(const float4*)(sc + c), h4 = *(const float4*)(sh + c);
                    uint2 o;
                    o.x = pk2(v[k][i].x * rs * gg.x * (1.f + s4.x) + h4.x, v[k][i].y * rs * gg.y * (1.f + s4.y) + h4.y);
                    o.y = pk2(v[k][i].z * rs * gg.z * (1.f + s4.z) + h4.z, v[k][i].w * rs * gg.w * (1.f + s4.w) + h4.w);
                    *(uint2*)(HN + (size_t)row * 1024 + c) = o;
                }
            }
        }
    }
}

struct Chain { int samp, b, dir, h, T, NC, row0; };
__device__ __forceinline__ Chain decode_chain(int chain) {
    Chain c; c.samp = chain < 16; const int c2 = c.samp ? chain : chain - 16;
    c.b = c2 >> 3; c.dir = (c2 >> 2) & 1; c.h = c2 & 3; c.T = c.samp ? 2048 : 256; c.NC = c.T >> 6; c.row0 = c.samp ? 4096 + c.b * 2048 : c.b * 256; return c;
}

__device__ __forceinline__ void item_chunk(int item, int& chain, int& c) { if (item < 512) { chain = item >> 5; c = item & 31; } else { const int i2 = item - 512; chain = 16 + (i2 >> 2); c = i2 & 3; } }

__device__ __forceinline__ int chunk_item_of(int L) {
    const int dir = L & 1;
    if (L < 512) { const int k = L >> 1, b = k >> 7, h = (k >> 5) & 3, j = k & 31; return (b * 8 + dir * 4 + h) * 32 + (dir ? 31 - j : j); }
    const int k = (L - 512) >> 1, b = k >> 4, h = (k >> 2) & 3, j = k & 3; return 512 + (b * 8 + dir * 4 + h) * 4 + (dir ? 3 - j : j);
}
__device__ __forceinline__ void mlstm_m1(const P& p, unsigned char* smem, int item) {
    int chain, c; item_chunk(item, chain, c);
    const Chain ch = decode_chain(chain);
    int tid0 = p.tid; asm volatile("" : "+v"(tid0));
    const int tid = tid0, lane = tid & 63, wave = tid >> 6;
    bf16* sk = (bf16*)smem; bf16* skTw = sk + 64 * 72; bf16* svT = skTw + 64 * 72;
    float* fl = (float*)(svT + 144 * 72);
    float* s_logi = fl; float* s_logf = fl + 64; float* s_wsl = fl + 128;
    const bf16* PROJ = (const bf16*)(p.ws + WS_R + R_PROJ); const float* GATES = (const float*)(p.ws + WS_R + R_GATES);
    float* KV = (float*)(p.ws + WS_R + R_KV) + (size_t)item * 8256; float* MS = (float*)(p.ws + WS_R + R_MS) + item * 4;
    const float bi = p.in[18][ch.dir * 4 + ch.h], bfg = p.in[19][ch.dir * 4 + ch.h];
    lds_barrier();
    for (int i = tid; i < 16 * 72; i += NT) svT[128 * 72 + i] = (i < 64) ? (bf16)0x3F80 : (bf16)0;
    {
        const int i = tid >> 3, seg = tid & 7;
        const int tk = ch.dir == 0 ? c * 64 + i : ch.T - 1 - (c * 64 + i);
        const bf16* rowp = PROJ + (size_t)(ch.row0 + tk) * 3616;
        *(uint4*)(sk + i * 72 + seg * 8) = *(const uint4*)(rowp + 256 + ch.h * 64 + seg * 8);
        {
            const int i2 = tid & 63, vsl = tid >> 6;
            const int tkv = ch.dir == 0 ? c * 64 + i2 : ch.T - 1 - (c * 64 + i2);
            const bf16* vp = PROJ + (size_t)(ch.row0 + tkv) * 3616 + 512 + ch.h * 128 + vsl * 16;
            const uint4 v0 = *(const uint4*)vp, v1 = *(const uint4*)(vp + 8);
            const unsigned vu0[4] = {v0.x, v0.y, v0.z, v0.w}, vu1[4] = {v1.x, v1.y, v1.z, v1.w};
#pragma unroll
            for (int j = 0; j < 4; ++j) {
                svT[(vsl * 16 + 2 * j) * 72 + i2] = (bf16)(vu0[j] & 0xffff); svT[(vsl * 16 + 2 * j + 1) * 72 + i2] = (bf16)(vu0[j] >> 16);
                svT[(vsl * 16 + 8 + 2 * j) * 72 + i2] = (bf16)(vu1[j] & 0xffff); svT[(vsl * 16 + 8 + 2 * j + 1) * 72 + i2] = (bf16)(vu1[j] >> 16);
            }
        }
        if (tid < 64) {
            const int tk2 = ch.dir == 0 ? c * 64 + tid : ch.T - 1 - (c * 64 + tid);
            const float* gp = GATES + (size_t)(ch.row0 + tk2) * 32;
            s_logi[tid] = gp[ch.dir * 4 + ch.h] + bi;
            s_logf[tid] = -softplus_f(-(gp[8 + ch.dir * 4 + ch.h] + bfg));
        }
    }
    lds_barrier();
    if (wave == 0) {
        float bb = s_logf[lane];
#pragma unroll
        for (int o = 1; o < 64; o <<= 1) { const float t = __shfl_up(bb, o); if (lane >= o) bb += t; }
        const float a = s_logi[lane] - bb; float pm = a;
#pragma unroll
        for (int o = 1; o < 64; o <<= 1) { const float t = __shfl_up(pm, o); if (lane >= o) pm = fmaxf(pm, t); }
        const float blast = __shfl(bb, 63), mloc = blast + __shfl(pm, 63);
        s_wsl[lane] = __expf(blast + a - mloc);
        if (lane == 0) { MS[0] = blast; MS[1] = mloc; }
    }
    lds_barrier();
    {
        const int d = tid & 63, s0 = (tid >> 6) * 8; float t8[8];
#pragma unroll
        for (int j = 0; j < 8; ++j) t8[j] = b2f(sk[(s0 + j) * 72 + d]) * s_wsl[s0 + j];
        uint4 o; o.x = pk2(t8[0], t8[1]); o.y = pk2(t8[2], t8[3]); o.z = pk2(t8[4], t8[5]); o.w = pk2(t8[6], t8[7]);
        *(uint4*)(skTw + d * 72 + s0) = o;
    }
    lds_barrier();
    mm<144, 64, 64>(tid, svT, 72, skTw, 72, [&](int, int, int v, int d, float val) { if (v < 129) KV[v * 64 + d] = val; });
}

__device__ __forceinline__ void mlstm_m2(const P& p, int item) {
    const int chain = item / 18, e = (item % 18) * 512 + p.tid, v = e >> 6, d = e & 63;
    const Chain ch = decode_chain(chain);
    const int sidx = (ch.b * 2 + ch.dir) * 4 + ch.h;
    const int base = ch.samp ? chain * 32 : 512 + (chain - 16) * 4;
    const float* KV = (const float*)(p.ws + WS_R + R_KV); float* MS = (float*)(p.ws + WS_R + R_MS);
    bf16* CST = (bf16*)(p.ws + WS_W + W_CST);
    float Cv = 0.f, m = 0.f;
    if (ch.samp) { m = p.in[5][sidx]; if (v < 128) Cv = p.in[3][(size_t)sidx * 8192 + d * 128 + v]; else if (v == 128) Cv = p.in[4][sidx * 64 + d]; }
    for (int c0 = 0; c0 < ch.NC; c0 += 4) {
        float kv[4], bl[4], ml[4];
#pragma unroll
        for (int j = 0; j < 4; ++j) { const int it = base + c0 + j; kv[j] = (v < 129) ? __builtin_nontemporal_load(KV + (size_t)it * 8256 + e) : 0.f; bl[j] = MS[it * 4]; ml[j] = MS[it * 4 + 1]; }
#pragma unroll
        for (int j = 0; j < 4; ++j) {
            const int it = base + c0 + j;
            CST[(size_t)it * 9216 + e] = f2b(Cv);
            if (e == 0) MS[it * 4 + 2] = m;
            const float mnew = fmaxf(bl[j] + m, ml[j]);
            Cv = __expf(bl[j] + m - mnew) * Cv + __expf(ml[j] - mnew) * kv[j];
            m = mnew;
        }
    }
    if (!ch.samp) {
        if (v < 128) p.out[O_C + (size_t)sidx * 8192 + d * 128 + v] = Cv; else if (v == 128) p.out[O_N + sidx * 64 + d] = Cv;
        if (e == 0) p.out[O_M + sidx] = m;
    }
}

__device__ __forceinline__ void mlstm_m3(const P& p, unsigned char* smem, int item) {
    int chain, c; item_chunk(item, chain, c);
    const Chain ch = decode_chain(chain);
    int tid0 = p.tid; asm volatile("" : "+v"(tid0));
    const int tid = tid0, lane = tid & 63, wave = tid >> 6, r = lane & 15, q = lane >> 4;
    bf16* sq = (bf16*)smem; bf16* sk = sq + 64 * 72; bf16* svT = sk + 64 * 72; bf16* ssw = svT + 144 * 72; bf16* sCT = ssw + 64 * 72;
    float* fl = (float*)(sCT + 144 * 72);
    float* s_logi = fl; float* s_logf = fl + 64; float* s_b = fl + 128; float* s_mt = fl + 192; float* s_ai = fl + 256; float* s_den = fl + 320;
    const bf16* PROJ = (const bf16*)(p.ws + WS_R + R_PROJ); const float* GATES = (const float*)(p.ws + WS_R + R_GATES);
    bf16* HM = (bf16*)(p.ws + WS_R + R_HM);
    const bf16* CST = (const bf16*)(p.ws + WS_W + W_CST) + (size_t)item * 9216;
    const float m = ((const float*)(p.ws + WS_R + R_MS))[item * 4 + 2];
    const float bi = p.in[18][ch.dir * 4 + ch.h], bfg = p.in[19][ch.dir * 4 + ch.h];
    lds_barrier();
    for (int i = tid; i < 16 * 72; i += NT) svT[128 * 72 + i] = (i < 64) ? (bf16)0x3F80 : (bf16)0;
    for (int ci = tid; ci < 1152; ci += NT) *(uint4*)(sCT + (ci >> 3) * 72 + (ci & 7) * 8) = ld_nt16(CST + ci * 8);
    {
        const int i = tid >> 3, seg = tid & 7;
        const int tk = ch.dir == 0 ? c * 64 + i : ch.T - 1 - (c * 64 + i);
        const bf16* rowp = PROJ + (size_t)(ch.row0 + tk) * 3616;
        uint4 qv = *(const uint4*)(rowp + ch.h * 64 + seg * 8);
        const uint4 kv = *(const uint4*)(rowp + 256 + ch.h * 64 + seg * 8);
        unsigned* qu = (unsigned*)&qv;
#pragma unroll
        for (int j = 0; j < 4; ++j) { const float lo = b2f((bf16)(qu[j] & 0xffff)) * 0.125f, hi = b2f((bf16)(qu[j] >> 16)) * 0.125f; qu[j] = pk2(lo, hi); }
        *(uint4*)(sq + i * 72 + seg * 8) = qv; *(uint4*)(sk + i * 72 + seg * 8) = kv;
        {
            const int i2 = tid & 63, vsl = tid >> 6;
            const int tkv = ch.dir == 0 ? c * 64 + i2 : ch.T - 1 - (c * 64 + i2);
            const bf16* vp = PROJ + (size_t)(ch.row0 + tkv) * 3616 + 512 + ch.h * 128 + vsl * 16;
            const uint4 v0 = *(const uint4*)vp, v1 = *(const uint4*)(vp + 8);
            const unsigned vu0[4] = {v0.x, v0.y, v0.z, v0.w}, vu1[4] = {v1.x, v1.y, v1.z, v1.w};
#pragma unroll
            for (int j = 0; j < 4; ++j) {
                svT[(vsl * 16 + 2 * j) * 72 + i2] = (bf16)(vu0[j] & 0xffff); svT[(vsl * 16 + 2 * j + 1) * 72 + i2] = (bf16)(vu0[j] >> 16);
                svT[(vsl * 16 + 8 + 2 * j) * 72 + i2] = (bf16)(vu1[j] & 0xffff); svT[(vsl * 16 + 8 + 2 * j + 1) * 72 + i2] = (bf16)(vu1[j] >> 16);
            }
        }
        if (tid < 64) {
            const int tk2 = ch.dir == 0 ? c * 64 + tid : ch.T - 1 - (c * 64 + tid);
            const float* gp = GATES + (size_t)(ch.row0 + tk2) * 32;
            s_logi[tid] = gp[ch.dir * 4 + ch.h] + bi;
            s_logf[tid] = -softplus_f(-(gp[8 + ch.dir * 4 + ch.h] + bfg));
        }
    }
    lds_barrier();
    if (wave == 0) {
        float bb = s_logf[lane];
#pragma unroll
        for (int o = 1; o < 64; o <<= 1) { const float t = __shfl_up(bb, o); if (lane >= o) bb += t; }
        float pm = s_logi[lane] - bb;
#pragma unroll
        for (int o = 1; o < 64; o <<= 1) { const float t = __shfl_up(pm, o); if (lane >= o) pm = fmaxf(pm, t); }
        const float mt = bb + fmaxf(m, pm);
        s_b[lane] = bb; s_mt[lane] = mt; s_ai[lane] = __expf(bb + m - mt);
    }
    lds_barrier();
    const int tm = wave >> 1, vh = wave & 1, tq = tm * 16 + r;
    const bf16x8 qf0 = *(const bf16x8*)(sq + tq * 72 + q * 8), qf1 = *(const bf16x8*)(sq + tq * 72 + 32 + q * 8);
    bf16x8 pb[2];
    {
        f32x4 w4[4];
        const float bt = s_b[tq] - s_mt[tq];
#pragma unroll
        for (int j = 0; j < 4; ++j) {
            if (j <= tm) {
                const bf16x8 kf0 = *(const bf16x8*)(sk + (j * 16 + r) * 72 + q * 8), kf1 = *(const bf16x8*)(sk + (j * 16 + r) * 72 + 32 + q * 8);
                f32x4 z = {0.f, 0.f, 0.f, 0.f};
                z = mfma16(kf0, qf0, z); z = mfma16(kf1, qf1, z);
#pragma unroll
                for (int e = 0; e < 4; ++e) { const int sx = j * 16 + q * 4 + e; w4[j][e] = (sx <= tq) ? z[e] * __expf(bt - s_b[sx] + s_logi[sx]) : 0.f; }
            } else w4[j] = (f32x4){0.f, 0.f, 0.f, 0.f};
        }
#pragma unroll
        for (int ks = 0; ks < 2; ++ks) {
            const u32x4 pu = {pk2(w4[2 * ks][0], w4[2 * ks][1]), pk2(w4[2 * ks][2], w4[2 * ks][3]), pk2(w4[2 * ks + 1][0], w4[2 * ks + 1][1]), pk2(w4[2 * ks + 1][2], w4[2 * ks + 1][3])};
            pb[ks] = __builtin_bit_cast(bf16x8, pu);
        }
    }
    float num[5][4];
    const float ait = s_ai[tq];
#pragma unroll
    for (int it = 0; it < 5; ++it) {
        const int vt = vh * 5 + it;
        if (vt < 9) {
            f32x4 a1 = {0.f, 0.f, 0.f, 0.f}, a2 = {0.f, 0.f, 0.f, 0.f};
            const bf16x8 cf0 = *(const bf16x8*)(sCT + (vt * 16 + r) * 72 + q * 8), cf1 = *(const bf16x8*)(sCT + (vt * 16 + r) * 72 + 32 + q * 8);
            a1 = mfma16(cf0, qf0, a1); a1 = mfma16(cf1, qf1, a1);
#pragma unroll
            for (int ks = 0; ks < 2; ++ks) {
                const uint2 v0 = *(const uint2*)(svT + (vt * 16 + r) * 72 + (2 * ks) * 16 + 4 * q), v1 = *(const uint2*)(svT + (vt * 16 + r) * 72 + (2 * ks + 1) * 16 + 4 * q);
                const u32x4 vau = {v0.x, v0.y, v1.x, v1.y};
                a2 = mfma16(__builtin_bit_cast(bf16x8, vau), pb[ks], a2);
            }
#pragma unroll
            for (int e = 0; e < 4; ++e) num[it][e] = ait * a1[e] + a2[e];
            if (vt == 8 && q == 0) s_den[tq] = num[it][0];
        }
    }
    lds_barrier();
    {
        const float dn = fmaxf(fabsf(s_den[tq]), __expf(-s_mt[tq])), inv = __builtin_amdgcn_rcpf(dn);
        const int tk = ch.dir == 0 ? c * 64 + tq : ch.T - 1 - (c * 64 + tq);
        bf16* hp = HM + ((size_t)ch.dir * 8192 + ch.row0 + tk) * 512 + ch.h * 128 + q * 4;
#pragma unroll
        for (int it = 0; it < 5; ++it) {
            const int vt = vh * 5 + it;
            if (vt < 8) *(uint2*)(hp + vt * 16) = make_uint2(pk2(num[it][0] * inv, num[it][1] * inv), pk2(num[it][2] * inv, num[it][3] * inv));
        }
    }
}

__device__ __forceinline__ void delta_d1(const P& p, unsigned char* smem, int item) {
    int chain, c;
    if (item < 512) { chain = item >> 5; c = item & 31; } else { const int i2 = item - 512; chain = 16 + (i2 >> 2); c = i2 & 3; }
    const Chain ch = decode_chain(chain);
    int tid0 = p.tid; asm volatile("" : "+v"(tid0));
    const int tid = tid0, lane = tid & 63, wave = tid >> 6;
    bf16* raw = (bf16*)smem;
    float* rhs = (float*)smem;
    bf16* skb = (bf16*)(smem + 67584); bf16* skk = skb + 64 * 136; bf16* sqq = skk + 64 * 136;
    float* sA = (float*)(smem + 67584 + 52224);
    float* s_gc = sA + 64 * 68; float* s_beta = s_gc + 64; float* s_g = s_beta + 64;
    float* scw = s_g + 64;
    const bf16* PROJ = (const bf16*)(p.ws + WS_R + R_PROJ); const float* GATES = (const float*)(p.ws + WS_R + R_GATES);
    unsigned char* rec = p.ws + WS_R + R_D1 + (size_t)item * REC;
    bf16* r_u = (bf16*)rec; bf16* r_w = (bf16*)(rec + 16384); bf16* r_qg = (bf16*)(rec + 32768); bf16* r_kdT = (bf16*)(rec + 49152); bf16* r_qk = (bf16*)(rec + 65536);
    const int lo = ch.dir == 0 ? c * 64 : ch.T - 64 - c * 64;
    lds_barrier();
    for (int ci = tid; ci < 3264; ci += NT) {
        const int which = ci / 1088, rem = ci % 1088, rr = rem >> 4, seg = rem & 15, tk = lo - 2 + rr;
        uint4 v = {0u, 0u, 0u, 0u};
        if (tk >= 0 && tk < ch.T) v = *(const uint4*)(PROJ + (size_t)(ch.row0 + tk) * 3616 + 1552 + which * 512 + ch.h * 128 + seg * 8);
        *(uint4*)(raw + (which * 68 + rr) * 160 + seg * 8) = v;
    }
    for (int ci = tid; ci < 1920; ci += NT) { const int j = ci / 384, w = (ci >> 7) % 3, chn = ci & 127; scw[ci] = p.in[21][j * 1536 + w * 512 + ch.h * 128 + chn]; }
    if (tid < 64) {
        const int tk = ch.dir == 0 ? lo + tid : lo + 63 - tid;
        const float* gp = GATES + (size_t)(ch.row0 + tk) * 32;
        s_beta[tid] = sigm_f(gp[16 + ch.dir * 4 + ch.h]);
        s_g[tid] = -__expf(p.in[22][ch.dir * 4 + ch.h]) * softplus_f(gp[24 + ch.dir * 4 + ch.h] + p.in[23][ch.dir * 4 + ch.h]);
    }
    lds_barrier();
    if (wave == 0) {
        float g = s_g[lane];
#pragma unroll
        for (int o = 1; o < 64; o <<= 1) { const float t = __shfl_up(g, o); if (lane >= o) g += t; }
        s_gc[lane] = g;
    }
    const int i = tid >> 3, seg = tid & 7;
    const int tl = ch.dir == 0 ? i : 63 - i;
    float qn[16], kn[16], vv[16];
    {
        const float* cw = scw + seg * 4;
        float sq_ = 0.f, sk_ = 0.f;
#pragma unroll
        for (int w = 0; w < 3; ++w) {
#pragma unroll
            for (int c4 = 0; c4 < 16; c4 += 4) {
                float a4[4] = {0.f, 0.f, 0.f, 0.f};
#pragma unroll
                for (int j = 0; j < 5; ++j) {
                    const float4 wv = *(const float4*)(cw + (j * 3 + w) * 128 + 8 * c4);
                    const uint2 rv = *(const uint2*)(raw + (w * 68 + tl + j) * 160 + seg * 4 + 8 * c4);
                    a4[0] += wv.x * b2f((bf16)(rv.x & 0xffff)); a4[1] += wv.y * b2f((bf16)(rv.x >> 16));
                    a4[2] += wv.z * b2f((bf16)(rv.y & 0xffff)); a4[3] += wv.w * b2f((bf16)(rv.y >> 16));
                }
#pragma unroll
                for (int k = 0; k < 4; ++k) {
                    const float v = silu_f(a4[k]);
                    if (w == 0) { qn[c4 + k] = v; sq_ += v * v; } else if (w == 1) { kn[c4 + k] = v; sk_ += v * v; } else vv[c4 + k] = v;
                }
                __builtin_amdgcn_sched_barrier(0);
            }
        }
        sq_ += __shfl_xor(sq_, 1); sq_ += __shfl_xor(sq_, 2); sq_ += __shfl_xor(sq_, 4);
        sk_ += __shfl_xor(sk_, 1); sk_ += __shfl_xor(sk_, 2); sk_ += __shfl_xor(sk_, 4);
        const float rq = rsqrtf(sq_ + 1e-6f) * 0.08838834764831845f, rk = rsqrtf(sk_ + 1e-6f);
#pragma unroll
        for (int cc = 0; cc < 16; ++cc) { qn[cc] *= rq; kn[cc] *= rk; }
    }
    lds_barrier();
    {
        const float beta = s_beta[i], gci = s_gc[i], egc = __expf(gci);
        unsigned wq[8], wk[8], wb[8], wg[8];
#pragma unroll
        for (int c2 = 0; c2 < 8; ++c2) {
            wq[c2] = pk2(qn[2 * c2], qn[2 * c2 + 1]); wk[c2] = pk2(kn[2 * c2], kn[2 * c2 + 1]);
            wb[c2] = pk2(kn[2 * c2] * beta, kn[2 * c2 + 1] * beta); wg[c2] = pk2(qn[2 * c2] * egc, qn[2 * c2 + 1] * egc);
        }
#pragma unroll
        for (int m = 0; m < 4; ++m) {
            const int cb = 32 * m + 4 * seg; const float be = beta * egc;
            *(uint2*)(sqq + i * 136 + cb) = make_uint2(wq[2 * m], wq[2 * m + 1]);
            *(uint2*)(skk + i * 136 + cb) = make_uint2(wk[2 * m], wk[2 * m + 1]);
            *(uint2*)(skb + i * 136 + cb) = make_uint2(wb[2 * m], wb[2 * m + 1]);
            *(uint2*)(r_qg + i * 128 + cb) = make_uint2(wg[2 * m], wg[2 * m + 1]);
            *(float4*)(rhs + i * 264 + cb) = make_float4(vv[4 * m] * beta, vv[4 * m + 1] * beta, vv[4 * m + 2] * beta, vv[4 * m + 3] * beta);
            *(float4*)(rhs + i * 264 + 128 + cb) = make_float4(kn[4 * m] * be, kn[4 * m + 1] * be, kn[4 * m + 2] * be, kn[4 * m + 3] * be);
        }
        if (tid == 0) *(float*)(rec + 73728) = __expf(s_gc[63]);
    }
    lds_barrier();
    mm<64, 64, 128>(tid, skb, 136, skk, 136, [&](int, int, int t, int s, float val) { sA[t * 68 + s] = (s < t) ? val * __expf(s_gc[t] - s_gc[s]) : 0.f; });
    lds_barrier();
    mm<64, 64, 128>(tid, sqq, 136, skk, 136, [&](int, int, int t, int s, float val) { skb[t * 72 + s] = f2b((s <= t) ? val * __expf(s_gc[t] - s_gc[s]) : 0.f); });
    lds_barrier();
    if (tid >= 256) {
        const int t2 = tid - 256;
#pragma unroll
        for (int u2 = 0; u2 < 2; ++u2) { const int ci = t2 + u2 * 256, row = ci >> 3, sg = ci & 7; *(uint4*)(r_qk + row * 64 + sg * 8) = *(const uint4*)(skb + row * 72 + sg * 8); }
        const int d = t2 & 127, sh = (t2 >> 7) * 32; const float g63 = s_gc[63];
#pragma unroll
        for (int g8 = 0; g8 < 4; ++g8) {
            float kv[8];
#pragma unroll
            for (int jj = 0; jj < 8; ++jj) { const int sx = sh + g8 * 8 + jj; kv[jj] = b2f(skk[sx * 136 + d]) * __expf(g63 - s_gc[sx]); }
            uint4 o; o.x = pk2(kv[0], kv[1]); o.y = pk2(kv[2], kv[3]); o.z = pk2(kv[4], kv[5]); o.w = pk2(kv[6], kv[7]);
            *(uint4*)(r_kdT + d * 64 + sh + g8 * 8) = o;
        }
    }
    float* sD = (float*)sqq;
    if (wave == 0) {
        const int blk = lane >> 4, col = lane & 15;
        float z[16];
#pragma unroll
        for (int ii = 0; ii < 16; ++ii) z[ii] = (ii == col) ? 1.f : 0.f;
#pragma unroll
        for (int ii = 1; ii < 16; ++ii)
#pragma unroll
            for (int s2 = 0; s2 < ii; ++s2) z[ii] -= sA[(blk * 16 + ii) * 68 + blk * 16 + s2] * z[s2];
#pragma unroll
        for (int ii = 0; ii < 16; ++ii) sD[(blk * 16 + ii) * 17 + col] = z[ii];
    }
    lds_barrier();
    {
        const int r = lane & 15, q = lane >> 4;
#pragma unroll
        for (int cti = 0; cti < 2; ++cti) {
            const int c0 = (wave + cti * 8) * 16;
            for (int tb = 0; tb < 4; ++tb) {
                float* cp = rhs + (tb * 16 + q * 4) * 264 + c0 + r;
                f32x4 acc = {cp[0], cp[264], cp[528], cp[792]};
                for (int ks = 0; ks < 4 * tb; ++ks) {
                    const float a = -sA[(tb * 16 + r) * 68 + ks * 4 + q];
                    const float b = rhs[(ks * 4 + q) * 264 + c0 + r];
                    acc = __builtin_amdgcn_mfma_f32_16x16x4f32(a, b, acc, 0, 0, 0);
                }
                cp[0] = acc[0]; cp[264] = acc[1]; cp[528] = acc[2]; cp[792] = acc[3];
                asm volatile("s_waitcnt lgkmcnt(0)" ::: "memory");
                __builtin_amdgcn_wave_barrier();
                f32x4 xv = {0.f, 0.f, 0.f, 0.f};
#pragma unroll
                for (int ks = 0; ks < 4; ++ks) {
                    const float a = sD[(tb * 16 + r) * 17 + ks * 4 + q];
                    const float b = rhs[(tb * 16 + ks * 4 + q) * 264 + c0 + r];
                    xv = __builtin_amdgcn_mfma_f32_16x16x4f32(a, b, xv, 0, 0, 0);
                }
                cp[0] = xv[0]; cp[264] = xv[1]; cp[528] = xv[2]; cp[792] = xv[3];
                asm volatile("s_waitcnt lgkmcnt(0)" ::: "memory");
                __builtin_amdgcn_wave_barrier();
            }
        }
    }
    lds_barrier();
    {
#pragma unroll
        for (int k = 0; k < 4; ++k) {
            const int ci = tid + k * NT, t = ci >> 5, g = ci & 31;
            const float4 x0 = *(const float4*)(rhs + t * 264 + g * 8), x1 = *(const float4*)(rhs + t * 264 + g * 8 + 4);
            uint4 o;
            if (g < 16) { o.x = pk2(x0.x, x0.y); o.y = pk2(x0.z, x0.w); o.z = pk2(x1.x, x1.y); o.w = pk2(x1.z, x1.w); *(uint4*)(r_u + t * 128 + g * 8) = o; }
            else { o.x = pk2(-x0.x, -x0.y); o.y = pk2(-x0.z, -x0.w); o.z = pk2(-x1.x, -x1.y); o.w = pk2(-x1.z, -x1.w); *(uint4*)(r_w + t * 128 + (g - 16) * 8) = o; }
        }
    }
}

__device__ __forceinline__ void delta_d2(const P& p, unsigned char* smem, int item) {
    const int chain = item >> 2, vs = (item & 3) * 32;
    const Chain ch = decode_chain(chain);
    int tid0 = p.tid; asm volatile("" : "+v"(tid0));
    const int tid = tid0, lane = tid & 63, wave = tid >> 6, r = lane & 15, q = lane >> 4;
    bf16* sST = (bf16*)smem; bf16* swn = sST + 32 * 136; bf16* sqg = swn + 64 * 136; bf16* su = sqg + 64 * 136; bf16* skdT = su + 64 * 32; bf16* sqk = skdT + 128 * 72; bf16* svnT = sqk + 64 * 72;
    bf16* HD = (bf16*)(p.ws + WS_R + R_HD);
    const int sidx = (ch.b * 2 + ch.dir) * 4 + ch.h;
    __syncthreads();
    float St[2][4], Ob[4];
#pragma unroll
    for (int it = 0; it < 2; ++it) {
        const int t_ = wave + it * NWV, tm = t_ / 8, tn = t_ % 8;
#pragma unroll
        for (int e = 0; e < 4; ++e) {
            const int v = tm * 16 + q * 4 + e, d = tn * 16 + r;
            const float val = ch.samp ? p.in[6][(size_t)sidx * 16384 + d * 128 + vs + v] : 0.f;
            St[it][e] = val; sST[v * 136 + d] = f2b(val);
        }
    }
    uint4 pb0, pc0, pd0, pb1, pc1, pd1, pq, pu; float gl_n;
#define D2_LOAD(rec_, t_) do { const unsigned char* r_ = (rec_); const int c0_ = (t_), c1_ = (t_) + NT; \
        pb0 = *(const uint4*)(r_ + 16384 + c0_ * 16); pc0 = *(const uint4*)(r_ + 32768 + c0_ * 16); pd0 = *(const uint4*)(r_ + 49152 + c0_ * 16); \
        pb1 = *(const uint4*)(r_ + 16384 + c1_ * 16); pc1 = *(const uint4*)(r_ + 32768 + c1_ * 16); pd1 = *(const uint4*)(r_ + 49152 + c1_ * 16); \
        pq = *(const uint4*)(r_ + 65536 + c0_ * 16); pu = *(const uint4*)(r_ + ((c0_ & 255) >> 2) * 256 + vs * 2 + (c0_ & 3) * 16); gl_n = *(const float*)(r_ + 73728); } while (0)
    const int recbase = ch.samp ? chain * 32 : 512 + (chain - 16) * 4;
    D2_LOAD(p.ws + WS_R + R_D1 + (size_t)recbase * REC, tid);
    for (int c = 0; c < ch.NC; ++c) {
        lds_barrier();
        int tidc = tid0; asm volatile("" : "+v"(tidc));
        const int tid = tidc;
        {
            const int c0 = tid, c1 = tid + NT;
            *(uint4*)(swn + (c0 >> 4) * 136 + (c0 & 15) * 8) = pb0; *(uint4*)(swn + (c1 >> 4) * 136 + (c1 & 15) * 8) = pb1;
            *(uint4*)(sqg + (c0 >> 4) * 136 + (c0 & 15) * 8) = pc0; *(uint4*)(sqg + (c1 >> 4) * 136 + (c1 & 15) * 8) = pc1;
            *(uint4*)(skdT + (c0 >> 3) * 72 + (c0 & 7) * 8) = pd0; *(uint4*)(skdT + (c1 >> 3) * 72 + (c1 & 7) * 8) = pd1;
            *(uint4*)(sqk + (c0 >> 3) * 72 + (c0 & 7) * 8) = pq;
            if (c0 < 256) *(uint4*)(su + (c0 >> 2) * 32 + (c0 & 3) * 8) = pu;
        }
        const float gl = gl_n;
        if (c + 1 < ch.NC) D2_LOAD(p.ws + WS_R + R_D1 + (size_t)(recbase + c + 1) * REC, tid);
        lds_barrier();
        const int lane_ = tid & 63, wave_ = tid >> 6, r_ = lane_ & 15, q_ = lane_ >> 4;
        {
            const int tm = wave_ >> 1, tn = wave_ & 1;
            f32x4 acc1 = {0.f, 0.f, 0.f, 0.f}, acc2 = {0.f, 0.f, 0.f, 0.f};
#pragma unroll
            for (int k = 0; k < 128; k += 32) {
                const bf16x8 bfr = *(const bf16x8*)(sST + (tn * 16 + r_) * 136 + k + q_ * 8);
                const bf16x8 a1 = *(const bf16x8*)(swn + (tm * 16 + r_) * 136 + k + q_ * 8);
                const bf16x8 a2 = *(const bf16x8*)(sqg + (tm * 16 + r_) * 136 + k + q_ * 8);
                acc1 = mfma16(a1, bfr, acc1); acc2 = mfma16(a2, bfr, acc2);
            }
            const int t0 = tm * 16 + q_ * 4, v = tn * 16 + r_;
            const float x0 = b2f(su[t0 * 32 + v]) + acc1[0], x1 = b2f(su[(t0 + 1) * 32 + v]) + acc1[1], x2 = b2f(su[(t0 + 2) * 32 + v]) + acc1[2], x3 = b2f(su[(t0 + 3) * 32 + v]) + acc1[3];
            *(uint2*)(svnT + v * 72 + t0) = make_uint2(pk2(x0, x1), pk2(x2, x3));
            Ob[0] = acc2[0]; Ob[1] = acc2[1]; Ob[2] = acc2[2]; Ob[3] = acc2[3];
        }
        lds_barrier();
        {
            const int tm = wave_ >> 1, tn = wave_ & 1;
            const bf16x8 oa0 = *(const bf16x8*)(sqk + (tm * 16 + r_) * 72 + q_ * 8), oa1 = *(const bf16x8*)(sqk + (tm * 16 + r_) * 72 + 32 + q_ * 8);
            const bf16x8 ob0 = *(const bf16x8*)(svnT + (tn * 16 + r_) * 72 + q_ * 8), ob1 = *(const bf16x8*)(svnT + (tn * 16 + r_) * 72 + 32 + q_ * 8);
            bf16x8 sa[2][2], sb[2][2];
#pragma unroll
            for (int it = 0; it < 2; ++it) {
                const int t_ = wave_ + it * NWV, tm4 = t_ >> 3, tn4 = t_ & 7;
                sa[it][0] = *(const bf16x8*)(svnT + (tm4 * 16 + r_) * 72 + q_ * 8); sa[it][1] = *(const bf16x8*)(svnT + (tm4 * 16 + r_) * 72 + 32 + q_ * 8);
                sb[it][0] = *(const bf16x8*)(skdT + (tn4 * 16 + r_) * 72 + q_ * 8); sb[it][1] = *(const bf16x8*)(skdT + (tn4 * 16 + r_) * 72 + 32 + q_ * 8);
            }
            f32x4 oacc = {0.f, 0.f, 0.f, 0.f};
            oacc = mfma16(oa0, ob0, oacc); oacc = mfma16(oa1, ob1, oacc);
            f32x4 sacc[2];
#pragma unroll
            for (int it = 0; it < 2; ++it) { sacc[it] = (f32x4){0.f, 0.f, 0.f, 0.f}; sacc[it] = mfma16(sa[it][0], sb[it][0], sacc[it]); sacc[it] = mfma16(sa[it][1], sb[it][1], sacc[it]); }
#pragma unroll
            for (int e = 0; e < 4; ++e) {
                const int t = tm * 16 + q_ * 4 + e, v = tn * 16 + r_;
                const int tk = ch.dir == 0 ? c * 64 + t : ch.T - 1 - (c * 64 + t);
                HD[((size_t)ch.dir * 8192 + ch.row0 + tk) * 512 + ch.h * 128 + vs + v] = f2b(Ob[e] + oacc[e]);
            }
#pragma unroll
            for (int it = 0; it < 2; ++it) {
                const int t_ = wave_ + it * NWV, tm4 = t_ >> 3, tn4 = t_ & 7;
#pragma unroll
                for (int e = 0; e < 4; ++e) {
                    const int v = tm4 * 16 + q_ * 4 + e, d = tn4 * 16 + r_;
                    const float nv = gl * St[it][e] + sacc[it][e]; St[it][e] = nv; sST[v * 136 + d] = f2b(nv);
                }
            }
        }
    }
#undef D2_LOAD
    if (!ch.samp) {
#pragma unroll
        for (int it = 0; it < 2; ++it) {
            const int t_ = wave + it * NWV, tm = t_ / 8, tn = t_ % 8;
#pragma unroll
            for (int e = 0; e < 4; ++e) { const int v = tm * 16 + q * 4 + e, d = tn * 16 + r; p.out[O_S + (size_t)sidx * 16384 + d * 128 + vs + v] = St[it][e]; }
        }
    }
}

__device__ __forceinline__ void ph_combine(const P& p) {
    const int lane = p.tid & 63, wave = p.tid >> 6;
    const bf16* PROJ = (const bf16*)(p.ws + WS_R + R_PROJ);
    const bf16* HM = (const bf16*)(p.ws + WS_R + R_HM); const bf16* HD = (const bf16*)(p.ws + WS_R + R_HD);
    bf16* MIX = (bf16*)(p.ws + WS_HN);
    const int col0 = lane * 16;
    const float* gp = (lane < 32) ? p.in[20] + col0 : p.in[24] + ((col0 - 512) & 127);
    float gv[16];
#pragma unroll
    for (int j = 0; j < 4; ++j) { const float4 t = *(const float4*)(gp + 4 * j); gv[4 * j] = t.x; gv[4 * j + 1] = t.y; gv[4 * j + 2] = t.z; gv[4 * j + 3] = t.w; }
    uint4 a0[4], a1[4], b0[4], b1[4], z0[4], z1[4];
#pragma unroll
    for (int k = 0; k < 4; ++k) {
        const int row = min(p.bid * NWV + wave + k * (int)gridDim.x * NWV, 8191);
        const bf16* s0 = (lane < 32) ? HM + (size_t)row * 512 + col0 : HD + (size_t)row * 512 + col0 - 512;
        const bf16* s1 = s0 + (size_t)8192 * 512;
        const bf16* zp = PROJ + (size_t)row * 3616 + ((lane < 32) ? 1024 + col0 : 3088 + col0 - 512);
        a0[k] = ld_nt16(s0); a1[k] = ld_nt16(s0 + 8); b0[k] = ld_nt16(s1); b1[k] = ld_nt16(s1 + 8);
        z0[k] = ld_nt16(zp); z1[k] = ld_nt16(zp + 8);
    }
#pragma unroll
    for (int k = 0; k < 4; ++k) {
        const int row = p.bid * NWV + wave + k * (int)gridDim.x * NWV;
        if (row < 8192) {
            const unsigned ua[8] = {a0[k].x, a0[k].y, a0[k].z, a0[k].w, a1[k].x, a1[k].y, a1[k].z, a1[k].w}, ub[8] = {b0[k].x, b0[k].y, b0[k].z, b0[k].w, b1[k].x, b1[k].y, b1[k].z, b1[k].w};
            const unsigned uz[8] = {z0[k].x, z0[k].y, z0[k].z, z0[k].w, z1[k].x, z1[k].y, z1[k].z, z1[k].w};
            float x[16]; float ss = 0.f;
#pragma unroll
            for (int j = 0; j < 8; ++j) {
                x[2 * j] = b2f((bf16)(ua[j] & 0xffff)) + b2f((bf16)(ub[j] & 0xffff)); x[2 * j + 1] = b2f((bf16)(ua[j] >> 16)) + b2f((bf16)(ub[j] >> 16));
                ss += x[2 * j] * x[2 * j] + x[2 * j + 1] * x[2 * j + 1];
            }
            ss += __shfl_xor(ss, 1); ss += __shfl_xor(ss, 2); ss += __shfl_xor(ss, 4);
            const float rs = rsqrtf(ss * (1.f / 128.f) + 1e-6f);
            float o[16];
#pragma unroll
            for (int j = 0; j < 8; ++j) {
                const float zl = b2f((bf16)(uz[j] & 0xffff)), zh = b2f((bf16)(uz[j] >> 16));
                o[2 * j] = x[2 * j] * rs * gv[2 * j] * ((lane < 32) ? sigm_f(zl) : silu_f(zl));
                o[2 * j + 1] = x[2 * j + 1] * rs * gv[2 * j + 1] * ((lane < 32) ? sigm_f(zh) : silu_f(zh));
            }
            uint4 a, b2;
            a.x = pk2(o[0], o[1]); a.y = pk2(o[2], o[3]); a.z = pk2(o[4], o[5]); a.w = pk2(o[6], o[7]);
            b2.x = pk2(o[8], o[9]); b2.y = pk2(o[10], o[11]); b2.z = pk2(o[12], o[13]); b2.w = pk2(o[14], o[15]);
            *(uint4*)(MIX + (size_t)row * 1024 + col0) = a; *(uint4*)(MIX + (size_t)row * 1024 + col0 + 8) = b2;
        }
    }
}

__device__ __forceinline__ void ph_attn(const P& p, unsigned char* smem) {
    const bf16* Qg = (const bf16*)(p.ws + WS_R + R_Q); const bf16* Kg = (const bf16*)(p.ws + WS_R + R_K); const bf16* VT = (const bf16*)(p.ws + WS_R + R_VT);
    const bf16* CK = (const bf16*)(p.ws + WS_CK); const bf16* CVT = (const bf16*)(p.ws + WS_CVT);
    bf16* MIX = (bf16*)(p.ws + WS_HN);
    const int pswz = (gridDim.x == 256) ? ((p.bid & 7) * 32 + (p.bid >> 3)) : p.bid;
    for (int pair = pswz; pair < 1024; pair += gridDim.x) {
        int tidc = p.tid; asm volatile("" : "+v"(tidc));
        const int tid = tidc, lane = tid & 63, wave = tid >> 6, r = lane & 15, q = lane >> 4;
        const int half = wave >> 2, wq = wave & 3, tl = tid & 255;
        unsigned char* base = smem + half * 64512;
        bf16* sQ = (bf16*)base; bf16* sK = sQ + 64 * 72; bf16* sV = sK + 128 * 72; bf16* sP = sV + 64 * 136 + wq * 16 * 136;
        float* sBias = (float*)(base + 62464);
        const int item = pair * 2 + half; const bool samp = item >= 1024;
        int b, h, qrow0, ntile, gr = 0, kr0 = 0;
        if (!samp) { b = item >> 6; h = (item >> 2) & 15; qrow0 = b * 256 + (item & 3) * 64; ntile = 2; }
        else { const int i2 = item - 1024; b = i2 >> 9; h = (i2 >> 5) & 15; gr = i2 & 31; qrow0 = 4096 + b * 2048 + gr * 64; ntile = 6; kr0 = min(max(gr - 4, 0), 24); }
        __syncthreads();
#pragma unroll
        for (int i = 0; i < 2; ++i) { const int c = tl + i * 256, row = c >> 3, seg = c & 7; *(uint4*)(sQ + row * 72 + seg * 8) = *(const uint4*)(Qg + (size_t)(qrow0 + row) * 1024 + h * 64 + seg * 8); }
        if (samp) for (int i = tl; i < 465; i += 256) sBias[i] = p.in[27][h * 465 + i];
        float m_run = -1e30f, l_run = 0.f;
        f32x4 O[4];
#pragma unroll
        for (int j = 0; j < 4; ++j) O[j] = (f32x4){0.f, 0.f, 0.f, 0.f};
        uint4 rk0, rk1, rk2, rk3, rv0, rv1, rv2, rv3;
#define ATT_LD1(kt_, i_, RK, RV) do { const int c = tl + (i_) * 256; \
            { const int key = c >> 3, seg = c & 7; const bf16* src; \
              if (!samp) src = Kg + (size_t)(b * 256 + (kt_) * 128 + key) * 1024 + h * 64 + seg * 8; \
              else if ((kt_) < 2) src = CK + (size_t)((b * 16 + h) * 256 + (kt_) * 128 + key) * 64 + seg * 8; \
              else src = Kg + (size_t)(4096 + b * 2048 + (kr0 + ((kt_) - 2) * 2) * 64 + key) * 1024 + h * 64 + seg * 8; \
              RK = *(const uint4*)src; } \
            { const int d = c >> 4, seg = c & 15; const bf16* src; \
              if (!samp) src = VT + ((size_t)(b * 16 + h) * 64 + d) * 256 + (kt_) * 128 + seg * 8; \
              else if ((kt_) < 2) src = CVT + ((size_t)(b * 16 + h) * 64 + d) * 256 + (kt_) * 128 + seg * 8; \
              else src = VT + 4194304 + ((size_t)(b * 16 + h) * 64 + d) * 2048 + (kr0 + ((kt_) - 2) * 2) * 64 + seg * 8; \
              RV = *(const uint4*)src; } } while (0)
#define ATT_LOAD(kt_) do { ATT_LD1(kt_, 0, rk0, rv0); ATT_LD1(kt_, 1, rk1, rv1); ATT_LD1(kt_, 2, rk2, rv2); ATT_LD1(kt_, 3, rk3, rv3); } while (0)
#define ATT_ST1(i_, RK, RV) do { const int c = tl + (i_) * 256; *(uint4*)(sK + (c >> 3) * 72 + (c & 7) * 8) = RK; *(uint4*)(sV + (c >> 4) * 136 + (c & 15) * 8) = RV; } while (0)
        ATT_LOAD(0);
        for (int kt = 0; kt < ntile; ++kt) {
            lds_barrier();
            ATT_ST1(0, rk0, rv0); ATT_ST1(1, rk1, rv1); ATT_ST1(2, rk2, rv2); ATT_ST1(3, rk3, rv3);
            if (kt + 1 < ntile) ATT_LOAD(kt + 1);
            lds_barrier();
            f32x4 s[8];
            {
                const bf16x8 qf0 = *(const bf16x8*)(sQ + (wq * 16 + r) * 72 + q * 8), qf1 = *(const bf16x8*)(sQ + (wq * 16 + r) * 72 + 32 + q * 8);
#pragma unroll
                for (int j = 0; j < 8; ++j) {
                    const bf16x8 kf0 = *(const bf16x8*)(sK + (j * 16 + r) * 72 + q * 8), kf1 = *(const bf16x8*)(sK + (j * 16 + r) * 72 + 32 + q * 8);
                    f32x4 z = {0.f, 0.f, 0.f, 0.f};
                    z = mfma16(kf0, qf0, z); s[j] = mfma16(kf1, qf1, z);
                }
            }
            if (samp && kt >= 2) {
                const int qc = wq * 16 + r, cs = min(max(qc - 8, 0), 48);
#pragma unroll
                for (int j = 0; j < 8; ++j) {
#pragma unroll
                    for (int e = 0; e < 4; ++e) {
                        const int kk = j * 16 + q * 4 + e, krow = kr0 + (kt - 2) * 2 + (kk >> 6), kc = kk & 63;
                        const bool valid = (unsigned)(kc - cs) < 16u;
                        s[j][e] = valid ? s[j][e] + sBias[valid ? (krow - gr + 7) * 31 + kc + 15 - qc : 0] : -1e30f;
                    }
                }
            }
            {
                float mx = s[0][0];
#pragma unroll
                for (int j = 0; j < 8; ++j)
#pragma unroll
                    for (int e = 0; e < 4; ++e) mx = fmaxf(mx, s[j][e]);
                mx = fmaxf(mx, __shfl_xor(mx, 16)); mx = fmaxf(mx, __shfl_xor(mx, 32));
                const float mn = fmaxf(m_run, mx), alpha = __expf(m_run - mn);
                m_run = mn;
                float rs = 0.f;
#pragma unroll
                for (int j = 0; j < 8; ++j)
#pragma unroll
                    for (int e = 0; e < 4; ++e) { const float pv = __expf(s[j][e] - mn); s[j][e] = pv; rs += pv; }
                rs += __shfl_xor(rs, 16); rs += __shfl_xor(rs, 32);
                l_run = l_run * alpha + rs;
#pragma unroll
                for (int jn = 0; jn < 4; ++jn) O[jn] = O[jn] * alpha;
            }
#pragma unroll
            for (int ks = 0; ks < 4; ++ks) {
                const u32x4 pbu = {pk2(s[2 * ks][0], s[2 * ks][1]), pk2(s[2 * ks][2], s[2 * ks][3]), pk2(s[2 * ks + 1][0], s[2 * ks + 1][1]), pk2(s[2 * ks + 1][2], s[2 * ks + 1][3])};
                const bf16x8 pb = __builtin_bit_cast(bf16x8, pbu);
#pragma unroll
                for (int jn = 0; jn < 4; ++jn) {
                    const uint2 v0 = *(const uint2*)(sV + (jn * 16 + r) * 136 + (2 * ks) * 16 + 4 * q), v1 = *(const uint2*)(sV + (jn * 16 + r) * 136 + (2 * ks + 1) * 16 + 4 * q);
                    const u32x4 vau = {v0.x, v0.y, v1.x, v1.y};
                    O[jn] = mfma16(__builtin_bit_cast(bf16x8, vau), pb, O[jn]);
                }
            }
        }
        {
            const float inv = __builtin_amdgcn_rcpf(l_run);
#pragma unroll
            for (int jn = 0; jn < 4; ++jn)
                *(uint2*)(MIX + (size_t)(qrow0 + wq * 16 + r) * 1024 + h * 64 + jn * 16 + q * 4) = make_uint2(pk2(O[jn][0] * inv, O[jn][1] * inv), pk2(O[jn][2] * inv, O[jn][3] * inv));
        }
    }
}


#define XB_TMO      128
#define XB_XCNT(j)  (256  + 64 * (j))
#define XB_XSUB(j)  (1280 + 64 * (j))
#define XB_XGEN(j)  (2304 + 64 * (j))
#define XB_TOP      3328
#define XB_TOPGEN   3392
#define XCD_BAR_WORDS 3456
#define XB_SPIN_CAP (1u << 22)
#define LAS __attribute__((address_space(3)))
__device__ __forceinline__ unsigned xb_ld(unsigned* p)              { return __hip_atomic_load(p, __ATOMIC_RELAXED, __HIP_MEMORY_SCOPE_AGENT); }
__device__ __forceinline__ unsigned xb_add(unsigned* p, unsigned v) { return __hip_atomic_fetch_add(p, v, __ATOMIC_RELAXED, __HIP_MEMORY_SCOPE_AGENT); }
__device__ __forceinline__ unsigned xb_xcc_id() { return (unsigned)__builtin_amdgcn_s_getreg((3 << 11) | 20) & 0xFu; }
#define XB_SPIN(cond, bar) do { unsigned _sp = 0; while (cond) { __builtin_amdgcn_s_sleep(1); \
    if ((++_sp & 255u) == 0u) { if (xb_ld(&(bar)[XB_TMO])) break; if (_sp > XB_SPIN_CAP) { atomicAdd(&(bar)[XB_TMO], 1u); break; } } } } while (0)
struct XcdBarrier { unsigned* bar; unsigned x; volatile LAS unsigned* st; };
__device__ __forceinline__ XcdBarrier xcd_barrier_post(unsigned* bar, volatile LAS unsigned* st) {
    XcdBarrier b; b.bar = bar; b.x = xb_xcc_id(); b.st = st;
    if (threadIdx.x == 0) (void)xb_add(&bar[XB_XCNT(b.x)], 1u);
    return b;
}
__device__ __forceinline__ void xcd_barrier_complete(unsigned* bar, unsigned x, unsigned& nloc, unsigned& nx) {
    const unsigned G = gridDim.x * gridDim.y * gridDim.z;
    unsigned sum, cnt, mine, sp = 0u;
    for (;;) {
        sum = 0u; cnt = 0u; mine = 0u;
#pragma unroll
        for (unsigned j = 0; j < 16; ++j) { const unsigned c = xb_ld(&bar[XB_XCNT(j)]); sum += c; cnt += (c > 0u) ? 1u : 0u; mine = (j == x) ? c : mine; }
        if (sum == G) break;
        __builtin_amdgcn_s_sleep(1);
        if ((++sp & 255u) == 0u) { if (xb_ld(&bar[XB_TMO])) break; if (sp > XB_SPIN_CAP) { atomicAdd(&bar[XB_TMO], 1u); break; } }
    }
    nloc = mine > 0u ? mine : 1u; nx = cnt > 0u ? cnt : 1u;
}
__device__ __forceinline__ void xcd_barrier(const XcdBarrier& b) {
    asm volatile("s_waitcnt vmcnt(0)" ::: "memory");
    __syncthreads();
    if (threadIdx.x == 0) {
        unsigned* bar = b.bar;
        __builtin_amdgcn_s_waitcnt(0);
        unsigned nloc = b.st[0], nx = b.st[1];
        if (nloc == 0u) { xcd_barrier_complete(bar, b.x, nloc, nx); b.st[0] = nloc; b.st[1] = nx; }
        const unsigned old = xb_add(&bar[XB_XSUB(b.x)], 1u);
        const unsigned gen = old / nloc;
        if (old + 1u == (gen + 1u) * nloc) {
            __builtin_amdgcn_fence(__ATOMIC_RELEASE, "agent");
            asm volatile("s_waitcnt vmcnt(0)" ::: "memory");
            const unsigned og = xb_add(&bar[XB_TOP], 1u);
            const unsigned tg = og / nx;
            if (og + 1u == (tg + 1u) * nx) xb_add(&bar[XB_TOPGEN], 1u);
            else XB_SPIN(xb_ld(&bar[XB_TOPGEN]) == tg, bar);
            __builtin_amdgcn_fence(__ATOMIC_ACQUIRE, "agent");
            xb_add(&bar[XB_XGEN(b.x)], 1u);
            asm volatile("s_waitcnt vmcnt(0)" ::: "memory");
        } else {
            XB_SPIN(xb_ld(&bar[XB_XGEN(b.x)]) == gen, bar);
            __builtin_amdgcn_fence(__ATOMIC_ACQUIRE, "agent");
            asm volatile("s_waitcnt vmcnt(0)" ::: "memory");
        }
    }
    __syncthreads();
}

#define PANEL_CNT_WORD 3584
__device__ __forceinline__ void panel_wait(unsigned* cnt) {
    asm volatile("s_waitcnt vmcnt(0)" ::: "memory");
    __syncthreads();
    if (threadIdx.x == 0) {
        __builtin_amdgcn_fence(__ATOMIC_RELEASE, "agent");
        asm volatile("s_waitcnt vmcnt(0)" ::: "memory");
        xb_add(cnt, 1u);
        unsigned sp = 0;
        while (xb_ld(cnt) < 8u) { __builtin_amdgcn_s_sleep(1); if (++sp > (1u << 24)) break; }
        __builtin_amdgcn_fence(__ATOMIC_ACQUIRE, "agent");
        asm volatile("s_waitcnt vmcnt(0)" ::: "memory");
    }
    __syncthreads();
}
#ifdef ONLY
#define EN(x) ((x) == ONLY)
#else
#define EN(x) true
#endif
constexpr int PPL = 13;
constexpr int N_PHASES = 1 + PPL * 2 + 1;
__device__ __forceinline__ void run_phase(P& p, int ph, unsigned char* smem, int rep) {
    int l = 0, s;
    if (ph == 0) s = 20; else if (ph == N_PHASES - 1) s = 21; else { l = (ph - 1) / PPL; s = (ph - 1) % PPL; }
    unsigned char* W = p.ws + WS_W; unsigned char* R = p.ws + WS_R;
    float* X = (float*)(p.ws + WS_X); const bf16* HN = (const bf16*)(p.ws + WS_HN); const float* MOD = (const float*)(p.ws + WS_MOD);
    PG8_LAS unsigned char* lds = (PG8_LAS unsigned char*)smem;
    bool do_norm = false, fin = false, has_res = false; int nl = l, nj = 0, resgi = 0, rbase = p.bid * NWV, rend = 8192, rstride = (int)gridDim.x * NWV; float coef = 0.5f;
    if (s == 20 || s == 0) {
        if (EN(12) && s == 20) ph_prologue(p, smem);
        if (s == 0 && l == 0) do_norm = true;
        if (EN(14) && (s == 20 || (s == 0 && l == 1))) { const int n = conv_count(l); for (int t = (s == 20) ? (int)((p.bid + gridDim.x - 32) % gridDim.x) : p.bid; t < n; t += gridDim.x) conv_weights_tile(p, smem, l, t); }
    } else if (s == 1 || s == 11) {
        if (EN(1)) {
            EpGU e{(bf16*)(R + R_ACT)}; pg8::StaticOrder S; S.init(8192, 5632, gridDim.x, p.bid);
            pg8::gemm_phase<EpGU, pg8::StaticOrder, true, true>(lds, pg8::Gemm{HN, (const bf16*)(W + (s == 1 ? W_GU0 : W_GU1)), 1024, 1024}, S, e, p.tid);
        }
    } else if (s == 2 || s == 9 || s == 12) {
        if (EN(2)) {
            EpPart e{(bf16*)(R + R_PART)};
            const bf16* A = (s == 9) ? HN : (const bf16*)(R + R_ACT);
            const bf16* Bt = (const bf16*)(W + (s == 9 ? W_OUT : (s == 2 ? W_D0 : W_D1)));
            const int ld = s == 9 ? 1024 : 2816;
            pg8::SplitK2Order S{p.bid, (int)gridDim.x, ld};
            pg8::gemm_phase<EpPart, pg8::SplitK2Order, true, true>(lds, pg8::Gemm{A, Bt, ld, ld / 2}, S, e, p.tid);
            const int pm = 4 * (p.bid & 7) + ((p.bid >> 3) & 3), sub = p.bid >> 5;
            panel_wait((unsigned*)(p.ws + WS_BAR) + PANEL_CNT_WORD + (l * 3 + (s == 2 ? 0 : (s == 9 ? 1 : 2))) * 32 + pm);
            do_norm = true; has_res = true; resgi = s == 2 ? 2 : (s == 9 ? 5 : 8); coef = s == 9 ? 1.0f : 0.5f;
            nj = s == 2 ? 1 : (s == 9 ? 2 : 0); nl = (s == 12) ? l + 1 : l; fin = (s == 12 && l == 1);
            rbase = pm * 256 + sub * 32; rend = rbase + 32; rstride = NWV;
        }
    } else if (s == 4) {
        if (l == 0) {
            if (EN(4)) {
                EpIn0 e{(bf16*)(R + R_PROJ), (float*)(R + R_GATES)}; pg8::StaticOrder S; S.init(8192, 3840, gridDim.x, p.bid);
                pg8::gemm_phase<EpIn0, pg8::StaticOrder, true, true>(lds, pg8::Gemm{HN, (const bf16*)(W + W_IN), 1024, 1024}, S, e, p.tid);
            }
        } else if (EN(15)) {
            EpIn1 e{(bf16*)(R + R_Q), (bf16*)(R + R_K), (bf16*)(R + R_VT), p.out + O_K, p.out + O_V}; pg8::StaticOrder S; S.init(8192, 3072, gridDim.x, p.bid);
            pg8::gemm_phase<EpIn1, pg8::StaticOrder, true, true>(lds, pg8::Gemm{HN, (const bf16*)(W + W_IN), 1024, 1024}, S, e, p.tid);
        }
    } else if (s == 5) {
        if (l == 0) {
            if (EN(5) && !(rep && PROBE == 9)) { { int t = p.tid; asm volatile("" : "+v"(t)); p.tid = t; } for (int t = (gridDim.x == 256 ? (p.bid & 7) * 32 + (p.bid >> 3) : p.bid); t < 1024; t += gridDim.x) mlstm_m1(p, smem, chunk_item_of(t)); }
            if (EN(16) && !(rep && PROBE == 8)) { { int t = p.tid; asm volatile("" : "+v"(t)); p.tid = t; } for (int t = (gridDim.x == 256 ? (p.bid & 7) * 32 + (p.bid >> 3) : p.bid); t < 1024; t += gridDim.x) delta_d1(p, smem, chunk_item_of(t)); }
        }
        else if (EN(17)) ph_attn(p, smem);
    } else if (s == 6) {
        if (l == 0) {
            const int nrest = (int)gridDim.x - 64;
            if (EN(18)) { if (nrest > 0) { if (p.bid >= 64) for (int t = p.bid - 64; t < 2592; t += nrest) mlstm_m2(p, t); } else { for (int t = p.bid; t < 2592; t += gridDim.x) mlstm_m2(p, t); } }
            if (EN(6)) {
                { int t = p.tid; asm volatile("" : "+v"(t)); p.tid = t; }
                if (nrest > 0) { for (int t = (p.bid < 64 ? p.bid : p.bid); t < 576; t += (p.bid < 64 ? 576 : nrest)) delta_d2(p, smem, t); }
                else { for (int t = p.bid; t < 576; t += gridDim.x) delta_d2(p, smem, t); }
            }
        }
    } else if (s == 7) {
        if (EN(19) && l == 0) { for (int t = (gridDim.x == 256 ? (p.bid & 7) * 32 + (p.bid >> 3) : p.bid); t < 1024; t += gridDim.x) mlstm_m3(p, smem, chunk_item_of(t)); }
    } else if (s == 8) {
        if (EN(7) && l == 0) ph_combine(p);
    }
    if (EN(0) && do_norm) ph_norm(p, fin ? 1 : nl, nj, has_res, l, resgi, coef, fin, rbase, rend, rstride, l == 0 && (s == 0 || s == 2));
}
__device__ __forceinline__ bool phase_empty(int ph) {
    if (ph == 0) return false;
    if (ph == N_PHASES - 1) return true;
    const int l = (ph - 1) / PPL, s = (ph - 1) % PPL;
    return s == 3 || s == 10 || (l == 1 && (s == 6 || s == 7 || s == 8));
}


__device__ __forceinline__ bool probe_match(int ph) {
#if PROBE == 0
    return false;
#else
    if (ph == 0) return PROBE == 5;
    if (ph == N_PHASES - 1) return PROBE == 6;
    const int l = (ph - 1) / PPL, s = (ph - 1) % PPL;
    if (PROBE == 1) return s == 1 || s == 4 || s == 11;
    if (PROBE == 11) return l == 1 && s == 0;
    if (PROBE == 12) return l == 0 && s == 8;
    if (PROBE == 2 || PROBE == 8 || PROBE == 9) return l == 0 && s == 5;
    if (PROBE == 3) return l == 0 && s == 6;
    if (PROBE == 4) return l == 1 && s == 5;
    if (PROBE == 6) return s == 0 || s == 3 || s == 10 || (l == 0 && s == 8);
    if (PROBE == 7) return ph == 1;
    if (PROBE == 10) return l == 0 && s == 7;
    return false;
#endif
}
__global__ void __launch_bounds__(NT) mega(P p) {
    extern __shared__ __attribute__((aligned(16))) unsigned char smem[];
    cg::grid_group grid = cg::this_grid();
    if (p.ph_hi > 100000) grid.sync();
    __shared__ uint4 xb_words;
    if (threadIdx.x == 0) xb_words = make_uint4(0u, 0u, 0u, 0u);
    __syncthreads();
    const XcdBarrier xb = xcd_barrier_post((unsigned*)(p.ws + WS_BAR), (volatile LAS unsigned*)&xb_words);
    const int wave_s = __builtin_amdgcn_readfirstlane((int)threadIdx.x >> 6);
    bool first = true;
    for (int ph = p.ph_lo; ph < p.ph_hi; ++ph) {
        if (phase_empty(ph)) continue;
        const int nrep = probe_match(ph) ? 2 : 1;
        for (int rep = 0; rep < nrep; ++rep) {
            if (!first) xcd_barrier(xb);
            first = false;
            { int t = (wave_s << 6) | (int)__builtin_amdgcn_mbcnt_hi(~0u, __builtin_amdgcn_mbcnt_lo(~0u, 0u)), b = (int)blockIdx.x; asm volatile("" : "+v"(t)); asm volatile("" : "+s"(b)); p.tid = t; p.bid = b; }
#if PROBE == 7
            if (rep) { for (int k = 0; k < 9; ++k) xcd_barrier(xb); continue; }
#endif
            run_phase(p, ph, smem, rep);
        }
    }
}

extern "C" void kernel_launch(void* const* d_in, const int* in_sizes, int n_in, void* d_out, int out_size, void* d_ws, size_t ws_size, hipStream_t stream) {
    static int grid_blocks = 0;
    if (!grid_blocks) {
        if (n_in != 29 || ws_size < WS_END) { fprintf(stderr, "kernel_launch: need 29 inputs and %zu B of workspace; got %d, %zu\n", (size_t)WS_END, n_in, ws_size); grid_blocks = -1; return; }
        int dev = 0, cus = 0, per_cu = 0;
        hipGetDevice(&dev);
        hipDeviceGetAttribute(&cus, hipDeviceAttributeMultiprocessorCount, dev);
        if (hipFuncSetAttribute((const void*)mega, hipFuncAttributeMaxDynamicSharedMemorySize, LDS_BYTES) != hipSuccess) { fprintf(stderr, "hipFuncSetAttribute failed\n"); grid_blocks = -1; return; }
        if (hipOccupancyMaxActiveBlocksPerMultiprocessor(&per_cu, (const void*)mega, NT, LDS_BYTES) != hipSuccess || per_cu < 1) { fprintf(stderr, "occupancy query failed (%d)\n", per_cu); per_cu = 1; (void)hipGetLastError(); }
        grid_blocks = cus * per_cu;
        if (grid_blocks < 256) { fprintf(stderr, "kernel_launch: needs 256 resident workgroups, have %d\n", grid_blocks); grid_blocks = -1; return; }
        grid_blocks = 256;
        fprintf(stderr, "kernel_launch: %d CUs x %d blocks\n", cus, per_cu);
    }
    if (grid_blocks < 0) return;
    if (hipMemsetAsync((char*)d_ws + WS_BAR, 0, 16384, stream) != hipSuccess) { fprintf(stderr, "memset failed\n"); return; }
    P p{};
    for (int i = 0; i < 29; ++i) p.in[i] = (const float*)d_in[i];
    p.out = (float*)d_out; p.ws = (unsigned char*)d_ws;
#if N_LAUNCH_MODE == 1
    p.ph_lo = 0; p.ph_hi = N_PHASES;
    void* args[] = {&p};
    hipError_t e = hipLaunchCooperativeKernel((const void*)mega, dim3(grid_blocks), dim3(NT), args, LDS_BYTES, stream);
    if (e != hipSuccess) fprintf(stderr, "cooperative launch failed: %s (grid %d)\n", hipGetErrorString(e), grid_blocks);
#else
    for (int ph = 0; ph < N_PHASES; ++ph) {
        if (ph > 0 && ph < N_PHASES - 1 && (ph - 1) / PPL == 1 && ((ph - 1) % PPL >= 6 && (ph - 1) % PPL <= 8)) continue;
        p.ph_lo = ph; p.ph_hi = ph + 1;
        hipLaunchKernelGGL(mega, dim3(grid_blocks), dim3(NT), LDS_BYTES, stream, p);
    }
#endif
}
```

```cpp
#include <hip/hip_runtime.h>
#include <hip/hip_cooperative_groups.h>
#include <cstdio>
#include <cstdint>
namespace cg = cooperative_groups;

#ifndef PROBE
#define PROBE 0
#endif
#ifndef N_LAUNCH_MODE
#define N_LAUNCH_MODE 1
#endif

typedef unsigned short bf16;
typedef short bf16x8 __attribute__((ext_vector_type(8)));
typedef float f32x4 __attribute__((ext_vector_type(4)));
typedef unsigned u32x4 __attribute__((ext_vector_type(4)));
typedef unsigned u32x2 __attribute__((ext_vector_type(2)));

#define NT 512
#define NWV 8
#define LDS_BYTES 147456

constexpr size_t WS_X = 0;
constexpr size_t WS_HN = WS_X + 33554432;
constexpr size_t WS_MOD = WS_HN + 16777216;
constexpr size_t WS_CK = WS_MOD + 221184;
constexpr size_t WS_CVT = WS_CK + 1048576;
constexpr size_t WS_W = WS_CVT + 1048576;
constexpr size_t W_GU0 = 0, W_D0 = 11534336, W_IN = 17301504, W_GU1 = 25165824, W_D1 = 36700160, W_OUT = 42467328, W_TOTAL = 44564480;
constexpr size_t W_CST = 0;
constexpr size_t WS_R = WS_W + W_TOTAL;
constexpr size_t R_ACT = 0;
constexpr size_t R_PROJ = 0, R_GATES = 59244544, R_HM = 60293120, R_HD = 77070336, R_D1 = 93847552, R_KV = 169607168, R_MS = 203423744, R_END = 203440128;
constexpr size_t R_PART = 67108864;
constexpr size_t R_Q = 0, R_K = 16777216, R_VT = 33554432;
constexpr size_t WS_BAR = WS_R + R_END;
constexpr size_t WS_END = WS_BAR + 16384;
constexpr int REC = 73984;

struct P { const float* in[29]; float* out; unsigned char* ws; int ph_lo, ph_hi, tid, bid; };

constexpr size_t O_YP = 0, O_YS = 4194304, O_C = 8388608, O_N = O_C + 1048576, O_M = O_N + 8192, O_S = O_M + 128, O_K = O_S + 2097152, O_V = O_K + 4194304;

__device__ __forceinline__ unsigned pk2(float a, float b) { unsigned r; asm("s_nop 1\n\tv_cvt_pk_bf16_f32 %0, %1, %2" : "=v"(r) : "v"(a), "v"(b)); return r; }
__device__ __forceinline__ bf16 f2b(float f) { return (bf16)(pk2(f, f) & 0xffffu); }
__device__ __forceinline__ float b2f(bf16 b) { return __uint_as_float(((unsigned)b) << 16); }

__device__ __forceinline__ float silu_f(float x) { return x * __builtin_amdgcn_rcpf(1.f + __expf(-x)); }
__device__ __forceinline__ float sigm_f(float x) { return __builtin_amdgcn_rcpf(1.f + __expf(-x)); }
__device__ __forceinline__ float softplus_f(float x) { return fmaxf(x, 0.f) + __logf(1.f + __expf(-fabsf(x))); }
__device__ __forceinline__ int grp_of(int row) { return row < 4096 ? 0 : 1 + ((row - 4096) >> 11); }
__device__ __forceinline__ uint4 ld_nt16(const void* p) { const u32x4 t = __builtin_nontemporal_load((const u32x4*)p); return make_uint4(t[0], t[1], t[2], t[3]); }
__device__ __forceinline__ void lds_barrier() { asm volatile("s_waitcnt lgkmcnt(0)\n\ts_barrier" ::: "memory"); }
template <int CTRL> __device__ __forceinline__ float dppf(float x) { return __builtin_bit_cast(float, __builtin_amdgcn_update_dpp(0, __builtin_bit_cast(int, x), CTRL, 0xF, 0xF, true)); }
__device__ __forceinline__ float row16_max(float x) { x = fmaxf(x, dppf<0x128>(x)); x = fmaxf(x, dppf<0x124>(x)); x = fmaxf(x, dppf<0x122>(x)); return fmaxf(x, dppf<0x121>(x)); }
__device__ __forceinline__ float row16_sum(float x) { x += dppf<0x128>(x); x += dppf<0x124>(x); x += dppf<0x122>(x); return x + dppf<0x121>(x); }
__device__ __forceinline__ f32x4 mfma16(bf16x8 a, bf16x8 b, f32x4 c) { return __builtin_amdgcn_mfma_f32_16x16x32_bf16(a, b, c, 0, 0, 0); }

template <int M, int N, int K, class F>
__device__ __forceinline__ void mm(int tid_, const bf16* A, int lda, const bf16* B, int ldb, F&& f) {
    const int lane = tid_ & 63, wave = tid_ >> 6, r = lane & 15, q = lane >> 4;
    constexpr int TN = N / 16, NTL = (M / 16) * TN, ITERS = (NTL + NWV - 1) / NWV;
#pragma unroll
    for (int it = 0; it < ITERS; ++it) {
        const int t = wave + it * NWV;
        if (t < NTL) {
            const int tm = t / TN, tn = t % TN;
            f32x4 acc = {0.f, 0.f, 0.f, 0.f};
#pragma unroll
            for (int k = 0; k < K; k += 32) {
                bf16x8 a = *(const bf16x8*)(A + (tm * 16 + r) * lda + k + q * 8);
                bf16x8 b = *(const bf16x8*)(B + (tn * 16 + r) * ldb + k + q * 8);
                acc = mfma16(a, b, acc);
            }
#pragma unroll
            for (int e = 0; e < 4; ++e) f(it, e, tm * 16 + q * 4 + e, tn * 16 + r, acc[e]);
        }
    }
}

namespace pg8 {
#define PG8_LAS __attribute__((address_space(3)))
typedef unsigned short bf16_t;
typedef short bf16x8 __attribute__((ext_vector_type(8)));
typedef float f32x4 __attribute__((ext_vector_type(4)));
constexpr int BM = 256, BK = 64, HALF = 128, HTB = HALF * BK * 2, STAGE_BYTES = 8 * HTB, NXCD = 8, WGM = 8;
__host__ __device__ __forceinline__ int lds_byte(int r, int c) { const int st = (r >> 4) * 2 + (c >> 5), rr = r & 15, cc = c & 31, ob = rr * 64 + cc * 2; return st * 1024 + (ob ^ (((ob >> 9) & 1) << 5)); }
__host__ __device__ __forceinline__ void stage_rc(int b, int& R, int& C) { const int st = b / 1024, sb = b % 1024, swz = sb ^ (((sb >> 9) & 1) << 5); R = (st >> 1) * 16 + swz / 64; C = (st & 1) * 32 + (swz % 64) / 2; }
__host__ __device__ __forceinline__ int perm32(int rho) { const int n = rho >> 4, i = rho & 15; return 8 * (i >> 2) + 4 * n + (i & 3); }
struct Unit { int pm, pn, ko; };
struct Gemm { const bf16_t* A; const bf16_t* Bt; int ld, K; };
struct StaticOrder {
    int nM, nN, nwg, G, c;
    __device__ void init(int M, int N, int G_, int c_) { nM = M / BM; nN = N / BM; nwg = nM * nN; G = G_; c = c_; }
    __device__ bool next(int i, Unit& u) const {
        const long L = (long)i * G + c; if (L >= nwg) return false;
        int wgid = (int)L; { const int q = nwg / NXCD, r = nwg % NXCD, xcd = wgid % NXCD, off = wgid / NXCD; wgid = (xcd < r ? xcd * (q + 1) : r * (q + 1) + (xcd - r) * q) + off; }
        const int nig = WGM * nN, gid = wgid / nig, fm = gid * WGM, gsz = (nM - fm) < WGM ? (nM - fm) : WGM;
        u.pm = fm + ((wgid % nig) % gsz); u.pn = (wgid % nig) / gsz; u.ko = 0; return true;
    }
    __device__ __forceinline__ void a_ready(const Unit&) const {}
    __device__ __forceinline__ void done(const Unit&) const {}
};
struct SplitK2Order {
    int c, G, kbytes;
    __device__ bool next(int i, Unit& u) const {
        const int L = i * G + c; if (L >= 256) return false;
        const int x = L & 7, o = L >> 3; u.pm = 4 * x + (o & 3); u.pn = (o >> 2) & 3; u.ko = (o >> 4) * kbytes; return true;
    }
    __device__ __forceinline__ void a_ready(const Unit&) const {}
    __device__ __forceinline__ void done(const Unit&) const {}
};
template <class Epi, class Sched, bool ALIGN_EPI = false, bool SP2 = false>
__device__ __forceinline__ void gemm_phase(PG8_LAS unsigned char* lds, const Gemm g, const Sched& S, const Epi& E, int tid_in) {
    const int tid = tid_in, wid = __builtin_amdgcn_readfirstlane(tid >> 6), lane = tid & 63, wr = wid >> 2, wc = wid & 3, fr = lane & 15, fq = lane >> 4;
    const int K = g.ld, nt = g.K / BK;
    unsigned voffA[2], voffB[2];
#pragma unroll
    for (int i = 0; i < 2; ++i) { int R, C; stage_rc(tid * 16 + i * 8192, R, C); const int Rb = Epi::PERM ? ((R & ~31) + perm32(R & 31)) : R;
        voffA[i] = (unsigned)(R * K + C) * 2u; voffB[i] = (unsigned)(Rb * K + C) * 2u; }
    const size_t kstep = (size_t)(BK * 2);
    const size_t hstep = (size_t)HALF * K * 2;
    const size_t tstep = 2 * hstep;
    const unsigned ldsw = (unsigned)wid * 1024u;
    const int aoff = lds_byte(wr * 64 + fr, fq * 8), boff = lds_byte(wc * 32 + fr, fq * 8);
#define PG8_SA(b, h) (((b) * 2 + (h)) * HTB)
#define PG8_SB(b, h) ((4 + (b) * 2 + (h)) * HTB)
#define PG8_STAGE(bufoff, gbase, voff) do { _Pragma("unroll") for (int _i = 0; _i < 2; ++_i) \
        __builtin_amdgcn_global_load_lds((const unsigned*)((const char*)(gbase) + (voff)[_i]), (PG8_LAS unsigned*)(lds + (bufoff) + ldsw + _i * 8192), 16, 0, 0); } while (0)
#define PG8_LDA(dst, b, h) do { _Pragma("unroll") for (int m = 0; m < 4; ++m) _Pragma("unroll") for (int k = 0; k < 2; ++k) dst[m][k] = *(const PG8_LAS bf16x8*)(lds + PG8_SA(b, h) + aoff + m * 2048 + k * 1024); } while (0)
#define PG8_LDB(dst, b, h) do { _Pragma("unroll") for (int n = 0; n < 2; ++n) _Pragma("unroll") for (int k = 0; k < 2; ++k) dst[n][k] = *(const PG8_LAS bf16x8*)(lds + PG8_SB(b, h) + boff + n * 2048 + k * 1024); } while (0)
#define PG8_MMA(ai, bj, At, Bt) do { __builtin_amdgcn_s_setprio(1); _Pragma("unroll") for (int m = 0; m < 4; ++m) _Pragma("unroll") for (int n = 0; n < 2; ++n) _Pragma("unroll") for (int k = 0; k < 2; ++k) \
        acc[ai][bj][m][n] = __builtin_amdgcn_mfma_f32_16x16x32_bf16(Bt[n][k], At[m][k], acc[ai][bj][m][n], 0, 0, 0); __builtin_amdgcn_s_setprio(0); } while (0)
#define PG8_WAIT_V(n) asm volatile("s_waitcnt vmcnt(" #n ")" ::: "memory")
#define PG8_WAIT_L(n) asm volatile("s_waitcnt lgkmcnt(" #n ")" ::: "memory")
#define PG8_BAR __builtin_amdgcn_s_barrier()
#define PG8_SCHED __builtin_amdgcn_sched_barrier(0)
    Unit cur, nxt; int ui = 0;
    if (!S.next(0, cur)) return;
    f32x4 acc[2][2][4][2];
#pragma unroll
    for (int a = 0; a < 2; ++a)
#pragma unroll
        for (int b = 0; b < 2; ++b)
#pragma unroll
            for (int m = 0; m < 4; ++m)
#pragma unroll
                for (int n = 0; n < 2; ++n) acc[a][b][m][n] = (f32x4){0.f, 0.f, 0.f, 0.f};
    bf16x8 At[4][2], B0[2][2], B1[2][2];
    const char* cA = (const char*)g.A + (size_t)cur.pm * tstep + cur.ko; const char* cB = (const char*)g.Bt + (size_t)cur.pn * tstep + cur.ko;
    S.a_ready(cur);
    if constexpr (SP2) {
        PG8_STAGE(PG8_SB(0, 0), cB, voffB); PG8_STAGE(PG8_SB(0, 1), cB + hstep, voffB); PG8_STAGE(PG8_SA(0, 0), cA, voffA); PG8_STAGE(PG8_SA(0, 1), cA + hstep, voffA);
        if (wr == 1) PG8_BAR;
        PG8_WAIT_V(2); PG8_BAR;
        PG8_STAGE(PG8_SB(1, 0), cB + kstep, voffB); PG8_STAGE(PG8_SA(1, 0), cA + kstep, voffA); PG8_STAGE(PG8_SB(1, 1), cB + hstep + kstep, voffB);
        PG8_WAIT_V(6); PG8_BAR;
    } else {
        PG8_STAGE(PG8_SB(0, 0), cB, voffB); PG8_STAGE(PG8_SA(0, 0), cA, voffA); PG8_STAGE(PG8_SB(0, 1), cB + hstep, voffB); PG8_STAGE(PG8_SA(0, 1), cA + hstep, voffA);
        if (wr == 1) PG8_BAR;
        PG8_WAIT_V(4); PG8_BAR;
        PG8_STAGE(PG8_SB(1, 0), cB + kstep, voffB); PG8_STAGE(PG8_SA(1, 0), cA + kstep, voffA); PG8_STAGE(PG8_SB(1, 1), cB + hstep + kstep, voffB);
        PG8_WAIT_V(6); PG8_BAR;
    }
    for (;;) {
        const bool has_next = S.next(ui + 1, nxt);
        const char* nA = has_next ? (const char*)g.A + (size_t)nxt.pm * tstep + nxt.ko : cA; const char* nB = has_next ? (const char*)g.Bt + (size_t)nxt.pn * tstep + nxt.ko : cB;
        for (int t = 0; t < nt; t += 2) {
            const bool last = (t == nt - 2);
            const char* a1 = cA + (size_t)(t + 1) * kstep;
            const char* a2 = last ? nA : cA + (size_t)(t + 2) * kstep; const char* b2 = last ? nB : cB + (size_t)(t + 2) * kstep;
            const char* a3 = a2 + kstep; const char* b3 = b2 + kstep;
            if (last && has_next) S.a_ready(nxt);
            if constexpr (SP2) {
            PG8_LDB(B0, 0, 0); PG8_LDB(B1, 0, 1); PG8_SCHED; PG8_LDA(At, 0, 0); PG8_STAGE(PG8_SA(1, 1), a1 + hstep, voffA);
            PG8_WAIT_V(8); PG8_WAIT_L(0); PG8_BAR; PG8_MMA(0, 0, At, B0); PG8_MMA(0, 1, At, B1); PG8_BAR; PG8_SCHED;
            PG8_LDA(At, 0, 1); PG8_STAGE(PG8_SB(0, 0), b2, voffB); PG8_STAGE(PG8_SB(0, 1), b2 + hstep, voffB); PG8_STAGE(PG8_SA(0, 0), a2, voffA);
            PG8_WAIT_V(8); PG8_WAIT_L(0); PG8_BAR; PG8_MMA(1, 0, At, B0); PG8_MMA(1, 1, At, B1); PG8_BAR; PG8_SCHED;
            PG8_LDB(B0, 1, 0); PG8_LDB(B1, 1, 1); PG8_SCHED; PG8_LDA(At, 1, 0); PG8_STAGE(PG8_SA(0, 1), a2 + hstep, voffA);
            PG8_WAIT_V(8); PG8_WAIT_L(0); PG8_BAR; PG8_MMA(0, 0, At, B0); PG8_MMA(0, 1, At, B1); PG8_BAR; PG8_SCHED;
            PG8_LDA(At, 1, 1); PG8_STAGE(PG8_SB(1, 0), b3, voffB); PG8_STAGE(PG8_SB(1, 1), b3 + hstep, voffB); PG8_STAGE(PG8_SA(1, 0), a3, voffA);
            PG8_WAIT_V(8); PG8_WAIT_L(0); PG8_BAR; PG8_MMA(1, 0, At, B0); PG8_MMA(1, 1, At, B1); PG8_BAR; PG8_SCHED;
            } else {
            PG8_LDB(B0, 0, 0); PG8_SCHED; PG8_LDA(At, 0, 0); PG8_STAGE(PG8_SA(1, 1), a1 + hstep, voffA);
            PG8_WAIT_L(8); PG8_BAR; PG8_WAIT_L(0); PG8_MMA(0, 0, At, B0); PG8_BAR; PG8_SCHED;
            PG8_LDB(B1, 0, 1); PG8_STAGE(PG8_SB(0, 0), b2, voffB);
            PG8_BAR; PG8_WAIT_L(0); PG8_MMA(0, 1, At, B1); PG8_BAR;
            PG8_LDA(At, 0, 1); PG8_STAGE(PG8_SA(0, 0), a2, voffA);
            PG8_BAR; PG8_WAIT_L(0); PG8_MMA(1, 0, At, B0); PG8_BAR; PG8_SCHED;
            PG8_STAGE(PG8_SB(0, 1), b2 + hstep, voffB);
            PG8_WAIT_V(6); PG8_BAR; PG8_MMA(1, 1, At, B1); PG8_BAR;
            PG8_LDB(B0, 1, 0); PG8_SCHED; PG8_LDA(At, 1, 0); PG8_STAGE(PG8_SA(0, 1), a2 + hstep, voffA);
            PG8_WAIT_L(8); PG8_BAR; PG8_WAIT_L(0); PG8_MMA(0, 0, At, B0); PG8_BAR; PG8_SCHED;
            PG8_LDB(B1, 1, 1); PG8_STAGE(PG8_SB(1, 0), b3, voffB);
            PG8_BAR; PG8_WAIT_L(0); PG8_MMA(0, 1, At, B1); PG8_BAR;
            PG8_LDA(At, 1, 1); PG8_STAGE(PG8_SA(1, 0), a3, voffA);
            PG8_BAR; PG8_WAIT_L(0); PG8_MMA(1, 0, At, B0); PG8_BAR; PG8_SCHED;
            PG8_STAGE(PG8_SB(1, 1), b3 + hstep, voffB);
            PG8_WAIT_V(6); PG8_BAR; PG8_MMA(1, 1, At, B1); PG8_BAR;
            }
        }
        if constexpr (ALIGN_EPI) { if (wr == 0) PG8_BAR; }
        if constexpr (!Epi::AFTER_DRAIN) { E(acc, cur, wr, wc, fr, fq); S.done(cur); }
        if (!has_next) break;
#pragma unroll
        for (int a = 0; a < 2; ++a)
#pragma unroll
            for (int b = 0; b < 2; ++b)
#pragma unroll
                for (int m = 0; m < 4; ++m)
#pragma unroll
                    for (int n = 0; n < 2; ++n) acc[a][b][m][n] = (f32x4){0.f, 0.f, 0.f, 0.f};
        cur = nxt; cA = nA; cB = nB; ++ui;
        if constexpr (ALIGN_EPI) { if (wr == 1) PG8_BAR; }
    }
    PG8_WAIT_V(0);
    if constexpr (!ALIGN_EPI) { if (wr == 0) PG8_BAR; }
    PG8_BAR;
    if constexpr (Epi::AFTER_DRAIN) { E.fused(acc, cur, wr, wc, fr, fq, lds, wid, lane); S.done(cur); }
#undef PG8_SA
#undef PG8_SB
#undef PG8_STAGE
#undef PG8_LDA
#undef PG8_LDB
#undef PG8_MMA
#undef PG8_WAIT_V
#undef PG8_WAIT_L
#undef PG8_BAR
#undef PG8_SCHED
}
}

struct EpGU {
    static constexpr bool PERM = true, AFTER_DRAIN = false; bf16* act;
    __device__ __forceinline__ void operator()(const f32x4 (&acc)[2][2][4][2], const pg8::Unit& u, int wr, int wc, int fr, int fq) const {
        const int f0 = u.pn * 128 + wc * 32 + fq * 8;
#pragma unroll
        for (int ai = 0; ai < 2; ++ai)
#pragma unroll
            for (int m = 0; m < 4; ++m) {
                const int row = u.pm * 256 + ai * 128 + wr * 64 + m * 16 + fr;
                const f32x4 g0 = acc[ai][0][m][0], g1 = acc[ai][0][m][1], u0 = acc[ai][1][m][0], u1 = acc[ai][1][m][1];
                uint4 o;
                o.x = pk2(silu_f(g0[0]) * u0[0], silu_f(g0[1]) * u0[1]); o.y = pk2(silu_f(g0[2]) * u0[2], silu_f(g0[3]) * u0[3]);
                o.z = pk2(silu_f(g1[0]) * u1[0], silu_f(g1[1]) * u1[1]); o.w = pk2(silu_f(g1[2]) * u1[2], silu_f(g1[3]) * u1[3]);
                *(uint4*)(act + (size_t)row * 2816 + f0) = o;
            }
    }
};
struct EpPart {
    static constexpr bool PERM = true, AFTER_DRAIN = false; bf16* part;
    __device__ __forceinline__ void operator()(const f32x4 (&acc)[2][2][4][2], const pg8::Unit& u, int wr, int wc, int fr, int fq) const {
        bf16* base = part + (u.ko ? 8388608 : 0);
#pragma unroll
        for (int ai = 0; ai < 2; ++ai)
#pragma unroll
            for (int m = 0; m < 4; ++m) {
                const int row = u.pm * 256 + ai * 128 + wr * 64 + m * 16 + fr;
#pragma unroll
                for (int bj = 0; bj < 2; ++bj) {
                    const f32x4 v0 = acc[ai][bj][m][0], v1 = acc[ai][bj][m][1];
                    uint4 o; o.x = pk2(v0[0], v0[1]); o.y = pk2(v0[2], v0[3]); o.z = pk2(v1[0], v1[1]); o.w = pk2(v1[2], v1[3]);
                    *(uint4*)(base + (size_t)row * 1024 + u.pn * 256 + bj * 128 + wc * 32 + fq * 8) = o;
                }
            }
    }
};
struct EpIn0 {
    static constexpr bool PERM = true, AFTER_DRAIN = false; bf16* proj; float* gates;
    __device__ __forceinline__ void operator()(const f32x4 (&acc)[2][2][4][2], const pg8::Unit& u, int wr, int wc, int fr, int fq) const {
#pragma unroll
        for (int bj = 0; bj < 2; ++bj) {
            const int c0 = u.pn * 256 + bj * 128 + wc * 32 + fq * 8;
            if (c0 < 3616) {
                int gi = -1;
                if (c0 >= 1536 && c0 < 1552) gi = c0 - 1536; else if (c0 >= 3600) gi = 16 + c0 - 3600;
#pragma unroll
                for (int ai = 0; ai < 2; ++ai)
#pragma unroll
                    for (int m = 0; m < 4; ++m) {
                        const int row = u.pm * 256 + ai * 128 + wr * 64 + m * 16 + fr;
                        const f32x4 v0 = acc[ai][bj][m][0], v1 = acc[ai][bj][m][1];
                        uint4 o; o.x = pk2(v0[0], v0[1]); o.y = pk2(v0[2], v0[3]); o.z = pk2(v1[0], v1[1]); o.w = pk2(v1[2], v1[3]);
                        *(uint4*)(proj + (size_t)row * 3616 + c0) = o;
                        if (gi >= 0) { *(f32x4*)(gates + row * 32 + gi) = v0; *(f32x4*)(gates + row * 32 + gi + 4) = v1; }
                    }
            }
        }
    }
};
struct EpIn1 {
    static constexpr bool PERM = true, AFTER_DRAIN = false; bf16* Q; bf16* Kb; bf16* VT; float* outk; float* outv;
    __device__ __forceinline__ void operator()(const f32x4 (&acc)[2][2][4][2], const pg8::Unit& u, int wr, int wc, int fr, int fq) const {
#pragma unroll
        for (int bj = 0; bj < 2; ++bj) {
            const int c0 = u.pn * 256 + bj * 128 + wc * 32 + fq * 8, sec = c0 >> 10, c2 = c0 & 1023, h = c2 >> 6, d0 = c2 & 63;
#pragma unroll
            for (int ai = 0; ai < 2; ++ai)
#pragma unroll
                for (int m = 0; m < 4; ++m) {
                    const int row = u.pm * 256 + ai * 128 + wr * 64 + m * 16 + fr;
                    const f32x4 v0 = acc[ai][bj][m][0], v1 = acc[ai][bj][m][1];
                    if (sec == 0) {
                        uint4 o; o.x = pk2(v0[0] * 0.125f, v0[1] * 0.125f); o.y = pk2(v0[2] * 0.125f, v0[3] * 0.125f); o.z = pk2(v1[0] * 0.125f, v1[1] * 0.125f); o.w = pk2(v1[2] * 0.125f, v1[3] * 0.125f);
                        *(uint4*)(Q + (size_t)row * 1024 + c2) = o;
                    } else if (sec == 1) {
                        uint4 o; o.x = pk2(v0[0], v0[1]); o.y = pk2(v0[2], v0[3]); o.z = pk2(v1[0], v1[1]); o.w = pk2(v1[2], v1[3]);
                        *(uint4*)(Kb + (size_t)row * 1024 + c2) = o;
                        if (row < 4096) { float* ok = outk + ((size_t)((row >> 8) * 16 + h) * 256 + (row & 255)) * 64 + d0; __builtin_nontemporal_store(v0, (f32x4*)ok); __builtin_nontemporal_store(v1, (f32x4*)(ok + 4)); }
                    } else {
                        if (row < 4096) {
                            const int b = row >> 8, t = row & 255;
                            bf16* vp = VT + ((size_t)(b * 16 + h) * 64 + d0) * 256 + t;
#pragma unroll
                            for (int jj = 0; jj < 4; ++jj) { vp[jj * 256] = f2b(v0[jj]); vp[(jj + 4) * 256] = f2b(v1[jj]); }
                            float* ov = outv + ((size_t)(b * 16 + h) * 256 + t) * 64 + d0; __builtin_nontemporal_store(v0, (f32x4*)ov); __builtin_nontemporal_store(v1, (f32x4*)(ov + 4));
                        } else {
                            const int r2 = row - 4096, b = r2 >> 11, t = r2 & 2047;
                            bf16* vp = VT + 4194304 + ((size_t)(b * 16 + h) * 64 + d0) * 2048 + t;
#pragma unroll
                            for (int jj = 0; jj < 4; ++jj) { vp[jj * 2048] = f2b(v0[jj]); vp[(jj + 4) * 2048] = f2b(v1[jj]); }
                        }
                    }
                }
        }
    }
};

__device__ __forceinline__ void adaln_tile(const P& p, unsigned char* smem, int tile) {
    float* sc = (float*)smem; float* red = sc + 3072;
    const int tid = p.tid;
    const float* cctx = p.in[9]; const float* cc = p.in[2];
    for (int i = tid; i < 3072; i += NT) { const int g = i >> 10, k = i & 1023; const float v = (g == 0) ? cctx[k] : cc[(g - 1) * 1024 + k]; sc[i] = silu_f(v); }
    __syncthreads();
    const int l = tile / 144, col0 = (tile % 144) * 64, cl = tid & 15, kg = tid >> 4;
    const float* W = p.in[10] + (size_t)l * 1024 * 9216 + col0 + cl * 4;
    float a0[4] = {0, 0, 0, 0}, a1[4] = {0, 0, 0, 0}, a2[4] = {0, 0, 0, 0};
    for (int k = kg; k < 1024; k += 32) {
        const f32x4 w4_ = __builtin_nontemporal_load((const f32x4*)(W + (size_t)k * 9216)); const float4 w = make_float4(w4_[0], w4_[1], w4_[2], w4_[3]);
        const float s0 = sc[k], s1 = sc[1024 + k], s2 = sc[2048 + k];
        a0[0] += s0 * w.x; a0[1] += s0 * w.y; a0[2] += s0 * w.z; a0[3] += s0 * w.w;
        a1[0] += s1 * w.x; a1[1] += s1 * w.y; a1[2] += s1 * w.z; a1[3] += s1 * w.w;
        a2[0] += s2 * w.x; a2[1] += s2 * w.y; a2[2] += s2 * w.z; a2[3] += s2 * w.w;
    }
#pragma unroll
    for (int j = 0; j < 4; ++j) { red[(kg * 3 + 0) * 64 + cl * 4 + j] = a0[j]; red[(kg * 3 + 1) * 64 + cl * 4 + j] = a1[j]; red[(kg * 3 + 2) * 64 + cl * 4 + j] = a2[j]; }
    __syncthreads();
    if (tid < 192) {
        const int g = tid >> 6, c = tid & 63; float s = 0.f;
        for (int k2 = 0; k2 < 32; ++k2) s += red[(k2 * 3 + g) * 64 + c];
        float* MOD = (float*)(p.ws + WS_MOD);
        MOD[(l * 3 + g) * 9216 + col0 + c] = s + p.in[11][l * 9216 + col0 + c];
    }
    __syncthreads();
}

__device__ __forceinline__ void conv_tile(const float* src, int srcld, bf16* dst, int dstld, int N, int mode, int tk, int tn, unsigned char* smem, int tid) {
    float* t = (float*)smem;
    const int k0 = tk * 128, n0 = tn * 128;
    float4 v[8];
#pragma unroll
    for (int u = 0; u < 8; ++u) {
        const int i = tid + u * NT, kk = i >> 5, n = n0 + (i & 31) * 4;
        v[u] = (float4){0.f, 0.f, 0.f, 0.f};
        if (n < N) { const f32x4 t4 = __builtin_nontemporal_load((const f32x4*)(src + (size_t)(k0 + kk) * srcld + n)); v[u] = make_float4(t4[0], t4[1], t4[2], t4[3]); }
    }
#pragma unroll
    for (int u = 0; u < 8; ++u) {
        const int i = tid + u * NT, kk = i >> 5, n4 = (i & 31) * 4;
        t[kk * 129 + n4] = v[u].x; t[kk * 129 + n4 + 1] = v[u].y; t[kk * 129 + n4 + 2] = v[u].z; t[kk * 129 + n4 + 3] = v[u].w;
    }
    __syncthreads();
    const int nl = tid >> 2, q4 = tid & 3, n = n0 + nl;
    const int row = mode == 0 ? n : (n / 128) * 256 + (n % 128) + (mode == 2 ? 128 : 0);
#pragma unroll
    for (int m = 0; m < 4; ++m) {
        const int kb = q4 * 8 + 32 * m;
        uint4 o;
        o.x = pk2(t[(kb + 0) * 129 + nl], t[(kb + 1) * 129 + nl]); o.y = pk2(t[(kb + 2) * 129 + nl], t[(kb + 3) * 129 + nl]);
        o.z = pk2(t[(kb + 4) * 129 + nl], t[(kb + 5) * 129 + nl]); o.w = pk2(t[(kb + 6) * 129 + nl], t[(kb + 7) * 129 + nl]);
        *(uint4*)(dst + (size_t)row * dstld + k0 + kb) = o;
    }
    __syncthreads();
}
__device__ __forceinline__ int conv_count(int l) { return 4 * 176 + 2 * 176 + 8 * (l == 0 ? 29 : 24) + 64; }
__device__ __forceinline__ void conv_weights_tile(const P& p, unsigned char* smem, int l, int idx) {
    unsigned char* W = p.ws + WS_W;
    const float* src; bf16* dst; int srcld, dstld, N, mode, tk, tn;
    const float* in13 = p.in[13]; const float* in14 = p.in[14]; const float* in16 = p.in[16]; const float* in25 = p.in[25]; const float* in17 = p.in[17]; const float* in26 = p.in[26];
    asm volatile("" : "+s"(in13), "+s"(in14), "+s"(in16), "+s"(in25), "+s"(in17), "+s"(in26));
    if (idx < 4 * 176) {
        const int f = idx / 352, which = (idx / 176) & 1, t = idx % 176; tk = t / 22; tn = t % 22;
        src = (which ? in14 : in13) + (size_t)(l * 2 + f) * 1024 * 2816; srcld = 2816; dst = (bf16*)(W + (f ? W_GU1 : W_GU0)); dstld = 1024; N = 2816; mode = 1 + which;
    } else if (idx < 6 * 176) {
        const int i2 = idx - 4 * 176, f = i2 / 176, t = i2 % 176; tk = t / 8; tn = t % 8;
        src = p.in[15] + (size_t)(l * 2 + f) * 2816 * 1024; srcld = 1024; dst = (bf16*)(W + (f ? W_D1 : W_D0)); dstld = 2816; N = 1024; mode = 0;
    } else {
        const int nin = (l == 0 ? 29 : 24);
        int i2 = idx - 6 * 176;
        if (i2 < 8 * nin) { tk = i2 / nin; tn = i2 % nin; src = l == 0 ? in16 : in25; srcld = N = (l == 0 ? 3616 : 3072); dst = (bf16*)(W + W_IN); dstld = 1024; mode = 0; }
        else { i2 -= 8 * nin; tk = i2 / 8; tn = i2 % 8; src = l == 0 ? in17 : in26; srcld = N = 1024; dst = (bf16*)(W + W_OUT); dstld = 1024; mode = 0; }
    }
    conv_tile(src, srcld, dst, dstld, N, mode, tk, tn, smem, p.tid);
}

__device__ __forceinline__ void ph_prologue(const P& p, unsigned char* smem) {
    for (int t = p.bid; t < 288; t += gridDim.x) adaln_tile(p, smem, t);
    bf16* CK = (bf16*)(p.ws + WS_CK); bf16* CVT = (bf16*)(p.ws + WS_CVT);
    for (int i = p.bid * NT + p.tid; i < 524288; i += gridDim.x * NT) {
        CK[i] = f2b(p.in[7][i]);
        const int d = i & 63, key = (i >> 6) & 255, bh = i >> 14;
        CVT[(bh * 64 + d) * 256 + key] = f2b(p.in[8][i]);
    }
}

__device__ __forceinline__ void ph_norm(const P& p, int l, int j, bool has_res, int resl, int resgi, float coef, bool fin, int rbase, int rend, int rstride, bool x_in) {
    const int lane = p.tid & 63, wave = p.tid >> 6;
    float* X = (float*)(p.ws + WS_X); bf16* HN = (bf16*)(p.ws + WS_HN);
    const float* MOD = (const float*)(p.ws + WS_MOD);
    const bf16* P0 = (const bf16*)(p.ws + WS_R + R_PART); const bf16* P1 = P0 + 8388608;
    const float* g = fin ? p.in[28] : p.in[12] + (l * 3 + j) * 1024;
    float4 v[4][4]; uint2 pa[4][4], pb[4][4];
#pragma unroll
    for (int k = 0; k < 4; ++k) {
        const int row = min(rbase + wave + k * rstride, 8191);
        const float* xs = x_in ? (row < 4096 ? p.in[0] + (size_t)row * 1024 : p.in[1] + (size_t)(row - 4096) * 1024) : X + (size_t)row * 1024;
#pragma unroll
        for (int i = 0; i < 4; ++i) {
            const int c = i * 256 + lane * 4;
            { const f32x4 t4 = __builtin_nontemporal_load((const f32x4*)(xs + c)); v[k][i] = make_float4(t4[0], t4[1], t4[2], t4[3]); }
            if (has_res) { const u32x2 ta = __builtin_nontemporal_load((const u32x2*)(P0 + (size_t)row * 1024 + c)), tb = __builtin_nontemporal_load((const u32x2*)(P1 + (size_t)row * 1024 + c)); pa[k][i] = make_uint2(ta[0], ta[1]); pb[k][i] = make_uint2(tb[0], tb[1]); }
        }
    }
#pragma unroll
    for (int k = 0; k < 4; ++k) {
        const int row = rbase + wave + k * rstride;
        if (row < rend) {
            const int grp = grp_of(row);
            float ss = 0.f;
#pragma unroll
            for (int i = 0; i < 4; ++i) {
                const int c = i * 256 + lane * 4;
                if (has_res) {
                    const uint2 a = pa[k][i], b = pb[k][i];
                    const float4 mg = *(const float4*)(MOD + (resl * 3 + grp) * 9216 + resgi * 1024 + c);
                    v[k][i].x += coef * mg.x * (b2f((bf16)(a.x & 0xffff)) + b2f((bf16)(b.x & 0xffff))); v[k][i].y += coef * mg.y * (b2f((bf16)(a.x >> 16)) + b2f((bf16)(b.x >> 16)));
                    v[k][i].z += coef * mg.z * (b2f((bf16)(a.y & 0xffff)) + b2f((bf16)(b.y & 0xffff))); v[k][i].w += coef * mg.w * (b2f((bf16)(a.y >> 16)) + b2f((bf16)(b.y >> 16)));
                    if (!fin) *(float4*)(X + (size_t)row * 1024 + c) = v[k][i];
                }
                ss += v[k][i].x * v[k][i].x + v[k][i].y * v[k][i].y + v[k][i].z * v[k][i].z + v[k][i].w * v[k][i].w;
            }
#pragma unroll
            for (int o = 32; o >= 1; o >>= 1) ss += __shfl_xor(ss, o);
            const float rs = rsqrtf(ss * (1.f / 1024.f) + 1e-6f);
            if (fin) {
#pragma unroll
                for (int i = 0; i < 4; ++i) {
                    const int c = i * 256 + lane * 4; const float4 gg = *(const float4*)(g + c);
                    float4 o = {v[k][i].x * rs * gg.x, v[k][i].y * rs * gg.y, v[k][i].z * rs * gg.z, v[k][i].w * rs * gg.w};
                    __builtin_nontemporal_store((f32x4){o.x, o.y, o.z, o.w}, (f32x4*)(p.out + (size_t)row * 1024 + c));
                }
            } else {
                const float* mod = MOD + (l * 3 + grp) * 9216;
                const float* sh = mod + (3 * j) * 1024; const float* sc = mod + (3 * j + 1) * 1024;
#pragma unroll
                for (int i = 0; i < 4; ++i) {
                    const int c = i * 256 + lane * 4;
                    const float4 gg = *(const float4*)(g + c), s4 = *(const float4*)(sc + c), h4 = *(const float4*)(sh + c);
                    uint2 o;
                    o.x = pk2(v[k][i].x * rs * gg.x * (1.f + s4.x) + h4.x, v[k][i].y * rs * gg.y * (1.f + s4.y) + h4.y);
                    o.y = pk2(v[k][i].z * rs * gg.z * (1.f + s4.z) + h4.z, v[k][i].w * rs * gg.w * (1.f + s4.w) + h4.w);
                    *(uint2*)(HN + (size_t)row * 1024 + c) = o;
                }
            }
        }
    }
}

struct Chain { int samp, b, dir, h, T, NC, row0; };
__device__ __forceinline__ Chain decode_chain(int chain) {
    Chain c; c.samp = chain < 16; const int c2 = c.samp ? chain : chain - 16;
    c.b = c2 >> 3; c.dir = (c2 >> 2) & 1; c.h = c2 & 3; c.T = c.samp ? 2048 : 256; c.NC = c.T >> 6; c.row0 = c.samp ? 4096 + c.b * 2048 : c.b * 256; return c;
}

__device__ __forceinline__ void item_chunk(int item, int& chain, int& c) { if (item < 512) { chain = item >> 5; c = item & 31; } else { const int i2 = item - 512; chain = 16 + (i2 >> 2); c = i2 & 3; } }

__device__ __forceinline__ int chunk_item_of(int L) {
    const int dir = L & 1;
    if (L < 512) { const int k = L >> 1, b = k >> 7, h = (k >> 5) & 3, j = k & 31; return (b * 8 + dir * 4 + h) * 32 + (dir ? 31 - j : j); }
    const int k = (L - 512) >> 1, b = k >> 4, h = (k >> 2) & 3, j = k & 3; return 512 + (b * 8 + dir * 4 + h) * 4 + (dir ? 3 - j : j);
}
__device__ __forceinline__ void mlstm_m1(const P& p, unsigned char* smem, int item) {
    int chain, c; item_chunk(item, chain, c);
    const Chain ch = decode_chain(chain);
    int tid0 = p.tid; asm volatile("" : "+v"(tid0));
    const int tid = tid0, lane = tid & 63, wave = tid >> 6;
    bf16* sk = (bf16*)smem; bf16* skTw = sk + 64 * 72; bf16* svT = skTw + 64 * 72;
    float* fl = (float*)(svT + 144 * 72);
    float* s_logi = fl; float* s_logf = fl + 64; float* s_wsl = fl + 128;
    const bf16* PROJ = (const bf16*)(p.ws + WS_R + R_PROJ); const float* GATES = (const float*)(p.ws + WS_R + R_GATES);
    float* KV = (float*)(p.ws + WS_R + R_KV) + (size_t)item * 8256; float* MS = (float*)(p.ws + WS_R + R_MS) + item * 4;
    const float bi = p.in[18][ch.dir * 4 + ch.h], bfg = p.in[19][ch.dir * 4 + ch.h];
    lds_barrier();
    for (int i = tid; i < 16 * 72; i += NT) svT[128 * 72 + i] = (i < 64) ? (bf16)0x3F80 : (bf16)0;
    {
        const int i = tid >> 3, seg = tid & 7;
        const int tk = ch.dir == 0 ? c * 64 + i : ch.T - 1 - (c * 64 + i);
        const bf16* rowp = PROJ + (size_t)(ch.row0 + tk) * 3616;
        *(uint4*)(sk + i * 72 + seg * 8) = *(const uint4*)(rowp + 256 + ch.h * 64 + seg * 8);
        {
            const int i2 = tid & 63, vsl = tid >> 6;
            const int tkv = ch.dir == 0 ? c * 64 + i2 : ch.T - 1 - (c * 64 + i2);
            const bf16* vp = PROJ + (size_t)(ch.row0 + tkv) * 3616 + 512 + ch.h * 128 + vsl * 16;
            const uint4 v0 = *(const uint4*)vp, v1 = *(const uint4*)(vp + 8);
            const unsigned vu0[4] = {v0.x, v0.y, v0.z, v0.w}, vu1[4] = {v1.x, v1.y, v1.z, v1.w};
#pragma unroll
            for (int j = 0; j < 4; ++j) {
                svT[(vsl * 16 + 2 * j) * 72 + i2] = (bf16)(vu0[j] & 0xffff); svT[(vsl * 16 + 2 * j + 1) * 72 + i2] = (bf16)(vu0[j] >> 16);
                svT[(vsl * 16 + 8 + 2 * j) * 72 + i2] = (bf16)(vu1[j] & 0xffff); svT[(vsl * 16 + 8 + 2 * j + 1) * 72 + i2] = (bf16)(vu1[j] >> 16);
            }
        }
        if (tid < 64) {
            const int tk2 = ch.dir == 0 ? c * 64 + tid : ch.T - 1 - (c * 64 + tid);
            const float* gp = GATES + (size_t)(ch.row0 + tk2) * 32;
            s_logi[tid] = gp[ch.dir * 4 + ch.h] + bi;
            s_logf[tid] = -softplus_f(-(gp[8 + ch.dir * 4 + ch.h] + bfg));
        }
    }
    lds_barrier();
    if (wave == 0) {
        float bb = s_logf[lane];
#pragma unroll
        for (int o = 1; o < 64; o <<= 1) { const float t = __shfl_up(bb, o); if (lane >= o) bb += t; }
        const float a = s_logi[lane] - bb; float pm = a;
#pragma unroll
        for (int o = 1; o < 64; o <<= 1) { const float t = __shfl_up(pm, o); if (lane >= o) pm = fmaxf(pm, t); }
        const float blast = __shfl(bb, 63), mloc = blast + __shfl(pm, 63);
        s_wsl[lane] = __expf(blast + a - mloc);
        if (lane == 0) { MS[0] = blast; MS[1] = mloc; }
    }
    lds_barrier();
    {
        const int d = tid & 63, s0 = (tid >> 6) * 8; float t8[8];
#pragma unroll
        for (int j = 0; j < 8; ++j) t8[j] = b2f(sk[(s0 + j) * 72 + d]) * s_wsl[s0 + j];
        uint4 o; o.x = pk2(t8[0], t8[1]); o.y = pk2(t8[2], t8[3]); o.z = pk2(t8[4], t8[5]); o.w = pk2(t8[6], t8[7]);
        *(uint4*)(skTw + d * 72 + s0) = o;
    }
    lds_barrier();
    mm<144, 64, 64>(tid, svT, 72, skTw, 72, [&](int, int, int v, int d, float val) { if (v < 129) KV[v * 64 + d] = val; });
}

__device__ __forceinline__ void mlstm_m2(const P& p, int item) {
    const int chain = item / 18, e = (item % 18) * 512 + p.tid, v = e >> 6, d = e & 63;
    const Chain ch = decode_chain(chain);
    const int sidx = (ch.b * 2 + ch.dir) * 4 + ch.h;
    const int base = ch.samp ? chain * 32 : 512 + (chain - 16) * 4;
    const float* KV = (const float*)(p.ws + WS_R + R_KV); float* MS = (float*)(p.ws + WS_R + R_MS);
    bf16* CST = (bf16*)(p.ws + WS_W + W_CST);
    float Cv = 0.f, m = 0.f;
    if (ch.samp) { m = p.in[5][sidx]; if (v < 128) Cv = p.in[3][(size_t)sidx * 8192 + d * 128 + v]; else if (v == 128) Cv = p.in[4][sidx * 64 + d]; }
    for (int c0 = 0; c0 < ch.NC; c0 += 4) {
        float kv[4], bl[4], ml[4];
#pragma unroll
        for (int j = 0; j < 4; ++j) { const int it = base + c0 + j; kv[j] = (v < 129) ? __builtin_nontemporal_load(KV + (size_t)it * 8256 + e) : 0.f; bl[j] = MS[it * 4]; ml[j] = MS[it * 4 + 1]; }
#pragma unroll
        for (int j = 0; j < 4; ++j) {
            const int it = base + c0 + j;
            CST[(size_t)it * 9216 + e] = f2b(Cv);
            if (e == 0) MS[it * 4 + 2] = m;
            const float mnew = fmaxf(bl[j] + m, ml[j]);
            Cv = __expf(bl[j] + m - mnew) * Cv + __expf(ml[j] - mnew) * kv[j];
            m = mnew;
        }
    }
    if (!ch.samp) {
        if (v < 128) p.out[O_C + (size_t)sidx * 8192 + d * 128 + v] = Cv; else if (v == 128) p.out[O_N + sidx * 64 + d] = Cv;
        if (e == 0) p.out[O_M + sidx] = m;
    }
}

__device__ __forceinline__ void mlstm_m3(const P& p, unsigned char* smem, int item) {
    int chain, c; item_chunk(item, chain, c);
    const Chain ch = decode_chain(chain);
    int tid0 = p.tid; asm volatile("" : "+v"(tid0));
    const int tid = tid0, lane = tid & 63, wave = tid >> 6, r = lane & 15, q = lane >> 4;
    bf16* sq = (bf16*)smem; bf16* sk = sq + 64 * 72; bf16* svT = sk + 64 * 72; bf16* ssw = svT + 144 * 72; bf16* sCT = ssw + 64 * 72;
    float* fl = (float*)(sCT + 144 * 72);
    float* s_logi = fl; float* s_logf = fl + 64; float* s_b = fl + 128; float* s_mt = fl + 192; float* s_ai = fl + 256; float* s_den = fl + 320;
    const bf16* PROJ = (const bf16*)(p.ws + WS_R + R_PROJ); const float* GATES = (const float*)(p.ws + WS_R + R_GATES);
    bf16* HM = (bf16*)(p.ws + WS_R + R_HM);
    const bf16* CST = (const bf16*)(p.ws + WS_W + W_CST) + (size_t)item * 9216;
    const float m = ((const float*)(p.ws + WS_R + R_MS))[item * 4 + 2];
    const float bi = p.in[18][ch.dir * 4 + ch.h], bfg = p.in[19][ch.dir * 4 + ch.h];
    lds_barrier();
    for (int i = tid; i < 16 * 72; i += NT) svT[128 * 72 + i] = (i < 64) ? (bf16)0x3F80 : (bf16)0;
    for (int ci = tid; ci < 1152; ci += NT) *(uint4*)(sCT + (ci >> 3) * 72 + (ci & 7) * 8) = ld_nt16(CST + ci * 8);
    {
        const int i = tid >> 3, seg = tid & 7;
        const int tk = ch.dir == 0 ? c * 64 + i : ch.T - 1 - (c * 64 + i);
        const bf16* rowp = PROJ + (size_t)(ch.row0 + tk) * 3616;
        uint4 qv = *(const uint4*)(rowp + ch.h * 64 + seg * 8);
        const uint4 kv = *(const uint4*)(rowp + 256 + ch.h * 64 + seg * 8);
        unsigned* qu = (unsigned*)&qv;
#pragma unroll
        for (int j = 0; j < 4; ++j) { const float lo = b2f((bf16)(qu[j] & 0xffff)) * 0.125f, hi = b2f((bf16)(qu[j] >> 16)) * 0.125f; qu[j] = pk2(lo, hi); }
        *(uint4*)(sq + i * 72 + seg * 8) = qv; *(uint4*)(sk + i * 72 + seg * 8) = kv;
        {
            const int i2 = tid & 63, vsl = tid >> 6;
            const int tkv = ch.dir == 0 ? c * 64 + i2 : ch.T - 1 - (c * 64 + i2);
            const bf16* vp = PROJ + (size_t)(ch.row0 + tkv) * 3616 + 512 + ch.h * 128 + vsl * 16;
            const uint4 v0 = *(const uint4*)vp, v1 = *(const uint4*)(vp + 8);
            const unsigned vu0[4] = {v0.x, v0.y, v0.z, v0.w}, vu1[4] = {v1.x, v1.y, v1.z, v1.w};
#pragma unroll
            for (int j = 0; j < 4; ++j) {
                svT[(vsl * 16 + 2 * j) * 72 + i2] = (bf16)(vu0[j] & 0xffff); svT[(vsl * 16 + 2 * j + 1) * 72 + i2] = (bf16)(vu0[j] >> 16);
                svT[(vsl * 16 + 8 + 2 * j) * 72 + i2] = (bf16)(vu1[j] & 0xffff); svT[(vsl * 16 + 8 + 2 * j + 1) * 72 + i2] = (bf16)(vu1[j] >> 16);
            }
        }
        if (tid < 64) {
            const int tk2 = ch.dir == 0 ? c * 64 + tid : ch.T - 1 - (c * 64 + tid);
            const float* gp = GATES + (size_t)(ch.row0 + tk2) * 32;
            s_logi[tid] = gp[ch.dir * 4 + ch.h] + bi;
            s_logf[tid] = -softplus_f(-(gp[8 + ch.dir * 4 + ch.h] + bfg));
        }
    }
    lds_barrier();
    if (wave == 0) {
        float bb = s_logf[lane];
#pragma unroll
        for (int o = 1; o < 64; o <<= 1) { const float t = __shfl_up(bb, o); if (lane >= o) bb += t; }
        float pm = s_logi[lane] - bb;
#pragma unroll
        for (int o = 1; o < 64; o <<= 1) { const float t = __shfl_up(pm, o); if (lane >= o) pm = fmaxf(pm, t); }
        const float mt = bb + fmaxf(m, pm);
        s_b[lane] = bb; s_mt[lane] = mt; s_ai[lane] = __expf(bb + m - mt);
    }
    lds_barrier();
    const int tm = wave >> 1, vh = wave & 1, tq = tm * 16 + r;
    const bf16x8 qf0 = *(const bf16x8*)(sq + tq * 72 + q * 8), qf1 = *(const bf16x8*)(sq + tq * 72 + 32 + q * 8);
    bf16x8 pb[2];
    {
        f32x4 w4[4];
        const float bt = s_b[tq] - s_mt[tq];
#pragma unroll
        for (int j = 0; j < 4; ++j) {
            if (j <= tm) {
                const bf16x8 kf0 = *(const bf16x8*)(sk + (j * 16 + r) * 72 + q * 8), kf1 = *(const bf16x8*)(sk + (j * 16 + r) * 72 + 32 + q * 8);
                f32x4 z = {0.f, 0.f, 0.f, 0.f};
                z = mfma16(kf0, qf0, z); z = mfma16(kf1, qf1, z);
#pragma unroll
                for (int e = 0; e < 4; ++e) { const int sx = j * 16 + q * 4 + e; w4[j][e] = (sx <= tq) ? z[e] * __expf(bt - s_b[sx] + s_logi[sx]) : 0.f; }
            } else w4[j] = (f32x4){0.f, 0.f, 0.f, 0.f};
        }
#pragma unroll
        for (int ks = 0; ks < 2; ++ks) {
            const u32x4 pu = {pk2(w4[2 * ks][0], w4[2 * ks][1]), pk2(w4[2 * ks][2], w4[2 * ks][3]), pk2(w4[2 * ks + 1][0], w4[2 * ks + 1][1]), pk2(w4[2 * ks + 1][2], w4[2 * ks + 1][3])};
            pb[ks] = __builtin_bit_cast(bf16x8, pu);
        }
    }
    float num[5][4];
    const float ait = s_ai[tq];
#pragma unroll
    for (int it = 0; it < 5; ++it) {
        const int vt = vh * 5 + it;
        if (vt < 9) {
            f32x4 a1 = {0.f, 0.f, 0.f, 0.f}, a2 = {0.f, 0.f, 0.f, 0.f};
            const bf16x8 cf0 = *(const bf16x8*)(sCT + (vt * 16 + r) * 72 + q * 8), cf1 = *(const bf16x8*)(sCT + (vt * 16 + r) * 72 + 32 + q * 8);
            a1 = mfma16(cf0, qf0, a1); a1 = mfma16(cf1, qf1, a1);
#pragma unroll
            for (int ks = 0; ks < 2; ++ks) {
                const uint2 v0 = *(const uint2*)(svT + (vt * 16 + r) * 72 + (2 * ks) * 16 + 4 * q), v1 = *(const uint2*)(svT + (vt * 16 + r) * 72 + (2 * ks + 1) * 16 + 4 * q);
                const u32x4 vau = {v0.x, v0.y, v1.x, v1.y};
                a2 = mfma16(__builtin_bit_cast(bf16x8, vau), pb[ks], a2);
            }
#pragma unroll
            for (int e = 0; e < 4; ++e) num[it][e] = ait * a1[e] + a2[e];
            if (vt == 8 && q == 0) s_den[tq] = num[it][0];
        }
    }
    lds_barrier();
    {
        const float dn = fmaxf(fabsf(s_den[tq]), __expf(-s_mt[tq])), inv = __builtin_amdgcn_rcpf(dn);
        const int tk = ch.dir == 0 ? c * 64 + tq : ch.T - 1 - (c * 64 + tq);
        bf16* hp = HM + ((size_t)ch.dir * 8192 + ch.row0 + tk) * 512 + ch.h * 128 + q * 4;
#pragma unroll
        for (int it = 0; it < 5; ++it) {
            const int vt = vh * 5 + it;
            if (vt < 8) *(uint2*)(hp + vt * 16) = make_uint2(pk2(num[it][0] * inv, num[it][1] * inv), pk2(num[it][2] * inv, num[it][3] * inv));
        }
    }
}

__device__ __forceinline__ void delta_d1(const P& p, unsigned char* smem, int item) {
    int chain, c;
    if (item < 512) { chain = item >> 5; c = item & 31; } else { const int i2 = item - 512; chain = 16 + (i2 >> 2); c = i2 & 3; }
    const Chain ch = decode_chain(chain);
    int tid0 = p.tid; asm volatile("" : "+v"(tid0));
    const int tid = tid0, lane = tid & 63, wave = tid >> 6;
    bf16* raw = (bf16*)smem;
    float* rhs = (float*)smem;
    bf16* skb = (bf16*)(smem + 67584); bf16* skk = skb + 64 * 136; bf16* sqq = skk + 64 * 136;
    float* sA = (float*)(smem + 67584 + 52224);
    float* s_gc = sA + 64 * 68; float* s_beta = s_gc + 64; float* s_g = s_beta + 64;
    float* scw = s_g + 64;
    const bf16* PROJ = (const bf16*)(p.ws + WS_R + R_PROJ); const float* GATES = (const float*)(p.ws + WS_R + R_GATES);
    unsigned char* rec = p.ws + WS_R + R_D1 + (size_t)item * REC;
    bf16* r_u = (bf16*)rec; bf16* r_w = (bf16*)(rec + 16384); bf16* r_qg = (bf16*)(rec + 32768); bf16* r_kdT = (bf16*)(rec + 49152); bf16* r_qk = (bf16*)(rec + 65536);
    const int lo = ch.dir == 0 ? c * 64 : ch.T - 64 - c * 64;
    lds_barrier();
    for (int ci = tid; ci < 3264; ci += NT) {
        const int which = ci / 1088, rem = ci % 1088, rr = rem >> 4, seg = rem & 15, tk = lo - 2 + rr;
        uint4 v = {0u, 0u, 0u, 0u};
        if (tk >= 0 && tk < ch.T) v = *(const uint4*)(PROJ + (size_t)(ch.row0 + tk) * 3616 + 1552 + which * 512 + ch.h * 128 + seg * 8);
        *(uint4*)(raw + (which * 68 + rr) * 160 + seg * 8) = v;
    }
    for (int ci = tid; ci < 1920; ci += NT) { const int j = ci / 384, w = (ci >> 7) % 3, chn = ci & 127; scw[ci] = p.in[21][j * 1536 + w * 512 + ch.h * 128 + chn]; }
    if (tid < 64) {
        const int tk = ch.dir == 0 ? lo + tid : lo + 63 - tid;
        const float* gp = GATES + (size_t)(ch.row0 + tk) * 32;
        s_beta[tid] = sigm_f(gp[16 + ch.dir * 4 + ch.h]);
        s_g[tid] = -__expf(p.in[22][ch.dir * 4 + ch.h]) * softplus_f(gp[24 + ch.dir * 4 + ch.h] + p.in[23][ch.dir * 4 + ch.h]);
    }
    lds_barrier();
    if (wave == 0) {
        float g = s_g[lane];
#pragma unroll
        for (int o = 1; o < 64; o <<= 1) { const float t = __shfl_up(g, o); if (lane >= o) g += t; }
        s_gc[lane] = g;
    }
    const int i = tid >> 3, seg = tid & 7;
    const int tl = ch.dir == 0 ? i : 63 - i;
    float qn[16], kn[16], vv[16];
    {
        const float* cw = scw + seg * 4;
        float sq_ = 0.f, sk_ = 0.f;
#pragma unroll
        for (int w = 0; w < 3; ++w) {
#pragma unroll
            for (int c4 = 0; c4 < 16; c4 += 4) {
                float a4[4] = {0.f, 0.f, 0.f, 0.f};
#pragma unroll
                for (int j = 0; j < 5; ++j) {
                    const float4 wv = *(const float4*)(cw + (j * 3 + w) * 128 + 8 * c4);
                    const uint2 rv = *(const uint2*)(raw + (w * 68 + tl + j) * 160 + seg * 4 + 8 * c4);
                    a4[0] += wv.x * b2f((bf16)(rv.x & 0xffff)); a4[1] += wv.y * b2f((bf16)(rv.x >> 16));
                    a4[2] += wv.z * b2f((bf16)(rv.y & 0xffff)); a4[3] += wv.w * b2f((bf16)(rv.y >> 16));
                }
#pragma unroll
                for (int k = 0; k < 4; ++k) {
                    const float v = silu_f(a4[k]);
                    if (w == 0) { qn[c4 + k] = v; sq_ += v * v; } else if (w == 1) { kn[c4 + k] = v; sk_ += v * v; } else vv[c4 + k] = v;
                }
                __builtin_amdgcn_sched_barrier(0);
            }
        }
        sq_ += __shfl_xor(sq_, 1); sq_ += __shfl_xor(sq_, 2); sq_ += __shfl_xor(sq_, 4);
        sk_ += __shfl_xor(sk_, 1); sk_ += __shfl_xor(sk_, 2); sk_ += __shfl_xor(sk_, 4);
        const float rq = rsqrtf(sq_ + 1e-6f) * 0.08838834764831845f, rk = rsqrtf(sk_ + 1e-6f);
#pragma unroll
        for (int cc = 0; cc < 16; ++cc) { qn[cc] *= rq; kn[cc] *= rk; }
    }
    lds_barrier();
    {
        const float beta = s_beta[i], gci = s_gc[i], egc = __expf(gci);
        unsigned wq[8], wk[8], wb[8], wg[8];
#pragma unroll
        for (int c2 = 0; c2 < 8; ++c2) {
            wq[c2] = pk2(qn[2 * c2], qn[2 * c2 + 1]); wk[c2] = pk2(kn[2 * c2], kn[2 * c2 + 1]);
            wb[c2] = pk2(kn[2 * c2] * beta, kn[2 * c2 + 1] * beta); wg[c2] = pk2(qn[2 * c2] * egc, qn[2 * c2 + 1] * egc);
        }
#pragma unroll
        for (int m = 0; m < 4; ++m) {
            const int cb = 32 * m + 4 * seg; const float be = beta * egc;
            *(uint2*)(sqq + i * 136 + cb) = make_uint2(wq[2 * m], wq[2 * m + 1]);
            *(uint2*)(skk + i * 136 + cb) = make_uint2(wk[2 * m], wk[2 * m + 1]);
            *(uint2*)(skb + i * 136 + cb) = make_uint2(wb[2 * m], wb[2 * m + 1]);
            *(uint2*)(r_qg + i * 128 + cb) = make_uint2(wg[2 * m], wg[2 * m + 1]);
            *(float4*)(rhs + i * 264 + cb) = make_float4(vv[4 * m] * beta, vv[4 * m + 1] * beta, vv[4 * m + 2] * beta, vv[4 * m + 3] * beta);
            *(float4*)(rhs + i * 264 + 128 + cb) = make_float4(kn[4 * m] * be, kn[4 * m + 1] * be, kn[4 * m + 2] * be, kn[4 * m + 3] * be);
        }
        if (tid == 0) *(float*)(rec + 73728) = __expf(s_gc[63]);
    }
    lds_barrier();
    mm<64, 64, 128>(tid, skb, 136, skk, 136, [&](int, int, int t, int s, float val) { sA[t * 68 + s] = (s < t) ? val * __expf(s_gc[t] - s_gc[s]) : 0.f; });
    lds_barrier();
    mm<64, 64, 128>(tid, sqq, 136, skk, 136, [&](int, int, int t, int s, float val) { skb[t * 72 + s] = f2b((s <= t) ? val * __expf(s_gc[t] - s_gc[s]) : 0.f); });
    lds_barrier();
    if (tid >= 256) {
        const int t2 = tid - 256;
#pragma unroll
        for (int u2 = 0; u2 < 2; ++u2) { const int ci = t2 + u2 * 256, row = ci >> 3, sg = ci & 7; *(uint4*)(r_qk + row * 64 + sg * 8) = *(const uint4*)(skb + row * 72 + sg * 8); }
        const int d = t2 & 127, sh = (t2 >> 7) * 32; const float g63 = s_gc[63];
#pragma unroll
        for (int g8 = 0; g8 < 4; ++g8) {
            float kv[8];
#pragma unroll
            for (int jj = 0; jj < 8; ++jj) { const int sx = sh + g8 * 8 + jj; kv[jj] = b2f(skk[sx * 136 + d]) * __expf(g63 - s_gc[sx]); }
            uint4 o; o.x = pk2(kv[0], kv[1]); o.y = pk2(kv[2], kv[3]); o.z = pk2(kv[4], kv[5]); o.w = pk2(kv[6], kv[7]);
            *(uint4*)(r_kdT + d * 64 + sh + g8 * 8) = o;
        }
    }
    float* sD = (float*)sqq;
    if (wave == 0) {
        const int blk = lane >> 4, col = lane & 15;
        float z[16];
#pragma unroll
        for (int ii = 0; ii < 16; ++ii) z[ii] = (ii == col) ? 1.f : 0.f;
#pragma unroll
        for (int ii = 1; ii < 16; ++ii)
#pragma unroll
            for (int s2 = 0; s2 < ii; ++s2) z[ii] -= sA[(blk * 16 + ii) * 68 + blk * 16 + s2] * z[s2];
#pragma unroll
        for (int ii = 0; ii < 16; ++ii) sD[(blk * 16 + ii) * 17 + col] = z[ii];
    }
    lds_barrier();
    {
        const int r = lane & 15, q = lane >> 4;
#pragma unroll
        for (int cti = 0; cti < 2; ++cti) {
            const int c0 = (wave + cti * 8) * 16;
            for (int tb = 0; tb < 4; ++tb) {
                float* cp = rhs + (tb * 16 + q * 4) * 264 + c0 + r;
                f32x4 acc = {cp[0], cp[264], cp[528], cp[792]};
                for (int ks = 0; ks < 4 * tb; ++ks) {
                    const float a = -sA[(tb * 16 + r) * 68 + ks * 4 + q];
                    const float b = rhs[(ks * 4 + q) * 264 + c0 + r];
                    acc = __builtin_amdgcn_mfma_f32_16x16x4f32(a, b, acc, 0, 0, 0);
                }
                cp[0] = acc[0]; cp[264] = acc[1]; cp[528] = acc[2]; cp[792] = acc[3];
                asm volatile("s_waitcnt lgkmcnt(0)" ::: "memory");
                __builtin_amdgcn_wave_barrier();
                f32x4 xv = {0.f, 0.f, 0.f, 0.f};
#pragma unroll
                for (int ks = 0; ks < 4; ++ks) {
                    const float a = sD[(tb * 16 + r) * 17 + ks * 4 + q];
                    const float b = rhs[(tb * 16 + ks * 4 + q) * 264 + c0 + r];
                    xv = __builtin_amdgcn_mfma_f32_16x16x4f32(a, b, xv, 0, 0, 0);
                }
                cp[0] = xv[0]; cp[264] = xv[1]; cp[528] = xv[2]; cp[792] = xv[3];
                asm volatile("s_waitcnt lgkmcnt(0)" ::: "memory");
                __builtin_amdgcn_wave_barrier();
            }
        }
    }
    lds_barrier();
    {
#pragma unroll
        for (int k = 0; k < 4; ++k) {
            const int ci = tid + k * NT, t = ci >> 5, g = ci & 31;
            const float4 x0 = *(const float4*)(rhs + t * 264 + g * 8), x1 = *(const float4*)(rhs + t * 264 + g * 8 + 4);
            uint4 o;
            if (g < 16) { o.x = pk2(x0.x, x0.y); o.y = pk2(x0.z, x0.w); o.z = pk2(x1.x, x1.y); o.w = pk2(x1.z, x1.w); *(uint4*)(r_u + t * 128 + g * 8) = o; }
            else { o.x = pk2(-x0.x, -x0.y); o.y = pk2(-x0.z, -x0.w); o.z = pk2(-x1.x, -x1.y); o.w = pk2(-x1.z, -x1.w); *(uint4*)(r_w + t * 128 + (g - 16) * 8) = o; }
        }
    }
}

__device__ __forceinline__ void delta_d2(const P& p, unsigned char* smem, int item) {
    const int chain = item >> 2, vs = (item & 3) * 32;
    const Chain ch = decode_chain(chain);
    int tid0 = p.tid; asm volatile("" : "+v"(tid0));
    const int tid = tid0, lane = tid & 63, wave = tid >> 6, r = lane & 15, q = lane >> 4;
    bf16* sST = (bf16*)smem; bf16* swn = sST + 32 * 136; bf16* sqg = swn + 64 * 136; bf16* su = sqg + 64 * 136; bf16* skdT = su + 64 * 32; bf16* sqk = skdT + 128 * 72; bf16* svnT = sqk + 64 * 72;
    bf16* HD = (bf16*)(p.ws + WS_R + R_HD);
    const int sidx = (ch.b * 2 + ch.dir) * 4 + ch.h;
    __syncthreads();
    float St[2][4], Ob[4];
#pragma unroll
    for (int it = 0; it < 2; ++it) {
        const int t_ = wave + it * NWV, tm = t_ / 8, tn = t_ % 8;
#pragma unroll
        for (int e = 0; e < 4; ++e) {
            const int v = tm * 16 + q * 4 + e, d = tn * 16 + r;
            const float val = ch.samp ? p.in[6][(size_t)sidx * 16384 + d * 128 + vs + v] : 0.f;
            St[it][e] = val; sST[v * 136 + d] = f2b(val);
        }
    }
    uint4 pb0, pc0, pd0, pb1, pc1, pd1, pq, pu; float gl_n;
#define D2_LOAD(rec_, t_) do { const unsigned char* r_ = (rec_); const int c0_ = (t_), c1_ = (t_) + NT; \
        pb0 = *(const uint4*)(r_ + 16384 + c0_ * 16); pc0 = *(const uint4*)(r_ + 32768 + c0_ * 16); pd0 = *(const uint4*)(r_ + 49152 + c0_ * 16); \
        pb1 = *(const uint4*)(r_ + 16384 + c1_ * 16); pc1 = *(const uint4*)(r_ + 32768 + c1_ * 16); pd1 = *(const uint4*)(r_ + 49152 + c1_ * 16); \
        pq = *(const uint4*)(r_ + 65536 + c0_ * 16); pu = *(const uint4*)(r_ + ((c0_ & 255) >> 2) * 256 + vs * 2 + (c0_ & 3) * 16); gl_n = *(const float*)(r_ + 73728); } while (0)
    const int recbase = ch.samp ? chain * 32 : 512 + (chain - 16) * 4;
    D2_LOAD(p.ws + WS_R + R_D1 + (size_t)recbase * REC, tid);
    for (int c = 0; c < ch.NC; ++c) {
        lds_barrier();
        int tidc = tid0; asm volatile("" : "+v"(tidc));
        const int tid = tidc;
        {
            const int c0 = tid, c1 = tid + NT;
            *(uint4*)(swn + (c0 >> 4) * 136 + (c0 & 15) * 8) = pb0; *(uint4*)(swn + (c1 >> 4) * 136 + (c1 & 15) * 8) = pb1;
            *(uint4*)(sqg + (c0 >> 4) * 136 + (c0 & 15) * 8) = pc0; *(uint4*)(sqg + (c1 >> 4) * 136 + (c1 & 15) * 8) = pc1;
            *(uint4*)(skdT + (c0 >> 3) * 72 + (c0 & 7) * 8) = pd0; *(uint4*)(skdT + (c1 >> 3) * 72 + (c1 & 7) * 8) = pd1;
            *(uint4*)(sqk + (c0 >> 3) * 72 + (c0 & 7) * 8) = pq;
            if (c0 < 256) *(uint4*)(su + (c0 >> 2) * 32 + (c0 & 3) * 8) = pu;
        }
        const float gl = gl_n;
        if (c + 1 < ch.NC) D2_LOAD(p.ws + WS_R + R_D1 + (size_t)(recbase + c + 1) * REC, tid);
        lds_barrier();
        const int lane_ = tid & 63, wave_ = tid >> 6, r_ = lane_ & 15, q_ = lane_ >> 4;
        {
            const int tm = wave_ >> 1, tn = wave_ & 1;
            f32x4 acc1 = {0.f, 0.f, 0.f, 0.f}, acc2 = {0.f, 0.f, 0.f, 0.f};
#pragma unroll
            for (int k = 0; k < 128; k += 32) {
                const bf16x8 bfr = *(const bf16x8*)(sST + (tn * 16 + r_) * 136 + k + q_ * 8);
                const bf16x8 a1 = *(const bf16x8*)(swn + (tm * 16 + r_) * 136 + k + q_ * 8);
                const bf16x8 a2 = *(const bf16x8*)(sqg + (tm * 16 + r_) * 136 + k + q_ * 8);
                acc1 = mfma16(a1, bfr, acc1); acc2 = mfma16(a2, bfr, acc2);
            }
            const int t0 = tm * 16 + q_ * 4, v = tn * 16 + r_;
            const float x0 = b2f(su[t0 * 32 + v]) + acc1[0], x1 = b2f(su[(t0 + 1) * 32 + v]) + acc1[1], x2 = b2f(su[(t0 + 2) * 32 + v]) + acc1[2], x3 = b2f(su[(t0 + 3) * 32 + v]) + acc1[3];
            *(uint2*)(svnT + v * 72 + t0) = make_uint2(pk2(x0, x1), pk2(x2, x3));
            Ob[0] = acc2[0]; Ob[1] = acc2[1]; Ob[2] = acc2[2]; Ob[3] = acc2[3];
        }
        lds_barrier();
        {
            const int tm = wave_ >> 1, tn = wave_ & 1;
            const bf16x8 oa0 = *(const bf16x8*)(sqk + (tm * 16 + r_) * 72 + q_ * 8), oa1 = *(const bf16x8*)(sqk + (tm * 16 + r_) * 72 + 32 + q_ * 8);
            const bf16x8 ob0 = *(const bf16x8*)(svnT + (tn * 16 + r_) * 72 + q_ * 8), ob1 = *(const bf16x8*)(svnT + (tn * 16 + r_) * 72 + 32 + q_ * 8);
            bf16x8 sa[2][2], sb[2][2];
#pragma unroll
            for (int it = 0; it < 2; ++it) {
                const int t_ = wave_ + it * NWV, tm4 = t_ >> 3, tn4 = t_ & 7;
                sa[it][0] = *(const bf16x8*)(svnT + (tm4 * 16 + r_) * 72 + q_ * 8); sa[it][1] = *(const bf16x8*)(svnT + (tm4 * 16 + r_) * 72 + 32 + q_ * 8);
                sb[it][0] = *(const bf16x8*)(skdT + (tn4 * 16 + r_) * 72 + q_ * 8); sb[it][1] = *(const bf16x8*)(skdT + (tn4 * 16 + r_) * 72 + 32 + q_ * 8);
            }
            f32x4 oacc = {0.f, 0.f, 0.f, 0.f};
            oacc = mfma16(oa0, ob0, oacc); oacc = mfma16(oa1, ob1, oacc);
            f32x4 sacc[2];
#pragma unroll
            for (int it = 0; it < 2; ++it) { sacc[it] = (f32x4){0.f, 0.f, 0.f, 0.f}; sacc[it] = mfma16(sa[it][0], sb[it][0], sacc[it]); sacc[it] = mfma16(sa[it][1], sb[it][1], sacc[it]); }
#pragma unroll
            for (int e = 0; e < 4; ++e) {
                const int t = tm * 16 + q_ * 4 + e, v = tn * 16 + r_;
                const int tk = ch.dir == 0 ? c * 64 + t : ch.T - 1 - (c * 64 + t);
                HD[((size_t)ch.dir * 8192 + ch.row0 + tk) * 512 + ch.h * 128 + vs + v] = f2b(Ob[e] + oacc[e]);
            }
#pragma unroll
            for (int it = 0; it < 2; ++it) {
                const int t_ = wave_ + it * NWV, tm4 = t_ >> 3, tn4 = t_ & 7;
#pragma unroll
                for (int e = 0; e < 4; ++e) {
                    const int v = tm4 * 16 + q_ * 4 + e, d = tn4 * 16 + r_;
                    const float nv = gl * St[it][e] + sacc[it][e]; St[it][e] = nv; sST[v * 136 + d] = f2b(nv);
                }
            }
        }
    }
#undef D2_LOAD
    if (!ch.samp) {
#pragma unroll
        for (int it = 0; it < 2; ++it) {
            const int t_ = wave + it * NWV, tm = t_ / 8, tn = t_ % 8;
#pragma unroll
            for (int e = 0; e < 4; ++e) { const int v = tm * 16 + q * 4 + e, d = tn * 16 + r; p.out[O_S + (size_t)sidx * 16384 + d * 128 + vs + v] = St[it][e]; }
        }
    }
}

__device__ __forceinline__ void ph_combine(const P& p) {
    const int lane = p.tid & 63, wave = p.tid >> 6;
    const bf16* PROJ = (const bf16*)(p.ws + WS_R + R_PROJ);
    const bf16* HM = (const bf16*)(p.ws + WS_R + R_HM); const bf16* HD = (const bf16*)(p.ws + WS_R + R_HD);
    bf16* MIX = (bf16*)(p.ws + WS_HN);
    const int col0 = lane * 16;
    const float* gp = (lane < 32) ? p.in[20] + col0 : p.in[24] + ((col0 - 512) & 127);
    float gv[16];
#pragma unroll
    for (int j = 0; j < 4; ++j) { const float4 t = *(const float4*)(gp + 4 * j); gv[4 * j] = t.x; gv[4 * j + 1] = t.y; gv[4 * j + 2] = t.z; gv[4 * j + 3] = t.w; }
    uint4 a0[4], a1[4], b0[4], b1[4], z0[4], z1[4];
#pragma unroll
    for (int k = 0; k < 4; ++k) {
        const int row = min(p.bid * NWV + wave + k * (int)gridDim.x * NWV, 8191);
        const bf16* s0 = (lane < 32) ? HM + (size_t)row * 512 + col0 : HD + (size_t)row * 512 + col0 - 512;
        const bf16* s1 = s0 + (size_t)8192 * 512;
        const bf16* zp = PROJ + (size_t)row * 3616 + ((lane < 32) ? 1024 + col0 : 3088 + col0 - 512);
        a0[k] = ld_nt16(s0); a1[k] = ld_nt16(s0 + 8); b0[k] = ld_nt16(s1); b1[k] = ld_nt16(s1 + 8);
        z0[k] = ld_nt16(zp); z1[k] = ld_nt16(zp + 8);
    }
#pragma unroll
    for (int k = 0; k < 4; ++k) {
        const int row = p.bid * NWV + wave + k * (int)gridDim.x * NWV;
        if (row < 8192) {
            const unsigned ua[8] = {a0[k].x, a0[k].y, a0[k].z, a0[k].w, a1[k].x, a1[k].y, a1[k].z, a1[k].w}, ub[8] = {b0[k].x, b0[k].y, b0[k].z, b0[k].w, b1[k].x, b1[k].y, b1[k].z, b1[k].w};
            const unsigned uz[8] = {z0[k].x, z0[k].y, z0[k].z, z0[k].w, z1[k].x, z1[k].y, z1[k].z, z1[k].w};
            float x[16]; float ss = 0.f;
#pragma unroll
            for (int j = 0; j < 8; ++j) {
                x[2 * j] = b2f((bf16)(ua[j] & 0xffff)) + b2f((bf16)(ub[j] & 0xffff)); x[2 * j + 1] = b2f((bf16)(ua[j] >> 16)) + b2f((bf16)(ub[j] >> 16));
                ss += x[2 * j] * x[2 * j] + x[2 * j + 1] * x[2 * j + 1];
            }
            ss += __shfl_xor(ss, 1); ss += __shfl_xor(ss, 2); ss += __shfl_xor(ss, 4);
            const float rs = rsqrtf(ss * (1.f / 128.f) + 1e-6f);
            float o[16];
#pragma unroll
            for (int j = 0; j < 8; ++j) {
                const float zl = b2f((bf16)(uz[j] & 0xffff)), zh = b2f((bf16)(uz[j] >> 16));
                o[2 * j] = x[2 * j] * rs * gv[2 * j] * ((lane < 32) ? sigm_f(zl) : silu_f(zl));
                o[2 * j + 1] = x[2 * j + 1] * rs * gv[2 * j + 1] * ((lane < 32) ? sigm_f(zh) : silu_f(zh));
            }
            uint4 a, b2;
            a.x = pk2(o[0], o[1]); a.y = pk2(o[2], o[3]); a.z = pk2(o[4], o[5]); a.w = pk2(o[6], o[7]);
            b2.x = pk2(o[8], o[9]); b2.y = pk2(o[10], o[11]); b2.z = pk2(o[12], o[13]); b2.w = pk2(o[14], o[15]);
            *(uint4*)(MIX + (size_t)row * 1024 + col0) = a; *(uint4*)(MIX + (size_t)row * 1024 + col0 + 8) = b2;
        }
    }
}

__device__ __forceinline__ void ph_attn(const P& p, unsigned char* smem) {
    const bf16* Qg = (const bf16*)(p.ws + WS_R + R_Q); const bf16* Kg = (const bf16*)(p.ws + WS_R + R_K); const bf16* VT = (const bf16*)(p.ws + WS_R + R_VT);
    const bf16* CK = (const bf16*)(p.ws + WS_CK); const bf16* CVT = (const bf16*)(p.ws + WS_CVT);
    bf16* MIX = (bf16*)(p.ws + WS_HN);
    const int pswz = (gridDim.x == 256) ? ((p.bid & 7) * 32 + (p.bid >> 3)) : p.bid;
    for (int pair = pswz; pair < 1024; pair += gridDim.x) {
        int tidc = p.tid; asm volatile("" : "+v"(tidc));
        const int tid = tidc, lane = tid & 63, wave = tid >> 6, r = lane & 15, q = lane >> 4;
        const int half = wave >> 2, wq = wave & 3, tl = tid & 255;
        unsigned char* base = smem + half * 64512;
        bf16* sQ = (bf16*)base; bf16* sK = sQ + 64 * 72; bf16* sV = sK + 128 * 72; bf16* sP = sV + 64 * 136 + wq * 16 * 136;
        float* sBias = (float*)(base + 62464);
        const int item = pair * 2 + half; const bool samp = item >= 1024;
        int b, h, qrow0, ntile, gr = 0, kr0 = 0;
        if (!samp) { b = item >> 6; h = (item >> 2) & 15; qrow0 = b * 256 + (item & 3) * 64; ntile = 2; }
        else { const int i2 = item - 1024; b = i2 >> 9; h = (i2 >> 5) & 15; gr = i2 & 31; qrow0 = 4096 + b * 2048 + gr * 64; ntile = 6; kr0 = min(max(gr - 4, 0), 24); }
        __syncthreads();
#pragma unroll
        for (int i = 0; i < 2; ++i) { const int c = tl + i * 256, row = c >> 3, seg = c & 7; *(uint4*)(sQ + row * 72 + seg * 8) = *(const uint4*)(Qg + (size_t)(qrow0 + row) * 1024 + h * 64 + seg * 8); }
        if (samp) for (int i = tl; i < 465; i += 256) sBias[i] = p.in[27][h * 465 + i];
        float m_run = -1e30f, l_run = 0.f;
        f32x4 O[4];
#pragma unroll
        for (int j = 0; j < 4; ++j) O[j] = (f32x4){0.f, 0.f, 0.f, 0.f};
        uint4 rk0, rk1, rk2, rk3, rv0, rv1, rv2, rv3;
#define ATT_LD1(kt_, i_, RK, RV) do { const int c = tl + (i_) * 256; \
            { const int key = c >> 3, seg = c & 7; const bf16* src; \
              if (!samp) src = Kg + (size_t)(b * 256 + (kt_) * 128 + key) * 1024 + h * 64 + seg * 8; \
              else if ((kt_) < 2) src = CK + (size_t)((b * 16 + h) * 256 + (kt_) * 128 + key) * 64 + seg * 8; \
              else src = Kg + (size_t)(4096 + b * 2048 + (kr0 + ((kt_) - 2) * 2) * 64 + key) * 1024 + h * 64 + seg * 8; \
              RK = *(const uint4*)src; } \
            { const int d = c >> 4, seg = c & 15; const bf16* src; \
              if (!samp) src = VT + ((size_t)(b * 16 + h) * 64 + d) * 256 + (kt_) * 128 + seg * 8; \
              else if ((kt_) < 2) src = CVT + ((size_t)(b * 16 + h) * 64 + d) * 256 + (kt_) * 128 + seg * 8; \
              else src = VT + 4194304 + ((size_t)(b * 16 + h) * 64 + d) * 2048 + (kr0 + ((kt_) - 2) * 2) * 64 + seg * 8; \
              RV = *(const uint4*)src; } } while (0)
#define ATT_LOAD(kt_) do { ATT_LD1(kt_, 0, rk0, rv0); ATT_LD1(kt_, 1, rk1, rv1); ATT_LD1(kt_, 2, rk2, rv2); ATT_LD1(kt_, 3, rk3, rv3); } while (0)
#define ATT_ST1(i_, RK, RV) do { const int c = tl + (i_) * 256; *(uint4*)(sK + (c >> 3) * 72 + (c & 7) * 8) = RK; *(uint4*)(sV + (c >> 4) * 136 + (c & 15) * 8) = RV; } while (0)
        ATT_LOAD(0);
        for (int kt = 0; kt < ntile; ++kt) {
            lds_barrier();
            ATT_ST1(0, rk0, rv0); ATT_ST1(1, rk1, rv1); ATT_ST1(2, rk2, rv2); ATT_ST1(3, rk3, rv3);
            if (kt + 1 < ntile) ATT_LOAD(kt + 1);
            lds_barrier();
            f32x4 s[8];
            {
                const bf16x8 qf0 = *(const bf16x8*)(sQ + (wq * 16 + r) * 72 + q * 8), qf1 = *(const bf16x8*)(sQ + (wq * 16 + r) * 72 + 32 + q * 8);
#pragma unroll
                for (int j = 0; j < 8; ++j) {
                    const bf16x8 kf0 = *(const bf16x8*)(sK + (j * 16 + r) * 72 + q * 8), kf1 = *(const bf16x8*)(sK + (j * 16 + r) * 72 + 32 + q * 8);
                    f32x4 z = {0.f, 0.f, 0.f, 0.f};
                    z = mfma16(kf0, qf0, z); s[j] = mfma16(kf1, qf1, z);
                }
            }
            if (samp && kt >= 2) {
                const int qc = wq * 16 + r, cs = min(max(qc - 8, 0), 48);
#pragma unroll
                for (int j = 0; j < 8; ++j) {
#pragma unroll
                    for (int e = 0; e < 4; ++e) {
                        const int kk = j * 16 + q * 4 + e, krow = kr0 + (kt - 2) * 2 + (kk >> 6), kc = kk & 63;
                        const bool valid = (unsigned)(kc - cs) < 16u;
                        s[j][e] = valid ? s[j][e] + sBias[valid ? (krow - gr + 7) * 31 + kc + 15 - qc : 0] : -1e30f;
                    }
                }
            }
            {
                float mx = s[0][0];
#pragma unroll
                for (int j = 0; j < 8; ++j)
#pragma unroll
                    for (int e = 0; e < 4; ++e) mx = fmaxf(mx, s[j][e]);
                mx = fmaxf(mx, __shfl_xor(mx, 16)); mx = fmaxf(mx, __shfl_xor(mx, 32));
                const float mn = fmaxf(m_run, mx), alpha = __expf(m_run - mn);
                m_run = mn;
                float rs = 0.f;
#pragma unroll
                for (int j = 0; j < 8; ++j)
#pragma unroll
                    for (int e = 0; e < 4; ++e) { const float pv = __expf(s[j][e] - mn); s[j][e] = pv; rs += pv; }
                rs += __shfl_xor(rs, 16); rs += __shfl_xor(rs, 32);
                l_run = l_run * alpha + rs;
#pragma unroll
                for (int jn = 0; jn < 4; ++jn) O[jn] = O[jn] * alpha;
            }
#pragma unroll
            for (int ks = 0; ks < 4; ++ks) {
                const u32x4 pbu = {pk2(s[2 * ks][0], s[2 * ks][1]), pk2(s[2 * ks][2], s[2 * ks][3]), pk2(s[2 * ks + 1][0], s[2 * ks + 1][1]), pk2(s[2 * ks + 1][2], s[2 * ks + 1][3])};
                const bf16x8 pb = __builtin_bit_cast(bf16x8, pbu);
#pragma unroll
                for (int jn = 0; jn < 4; ++jn) {
                    const uint2 v0 = *(const uint2*)(sV + (jn * 16 + r) * 136 + (2 * ks) * 16 + 4 * q), v1 = *(const uint2*)(sV + (jn * 16 + r) * 136 + (2 * ks + 1) * 16 + 4 * q);
                    const u32x4 vau = {v0.x, v0.y, v1.x, v1.y};
                    O[jn] = mfma16(__builtin_bit_cast(bf16x8, vau), pb, O[jn]);
                }
            }
        }
        {
            const float inv = __builtin_amdgcn_rcpf(l_run);
#pragma unroll
            for (int jn = 0; jn < 4; ++jn)
                *(uint2*)(MIX + (size_t)(qrow0 + wq * 16 + r) * 1024 + h * 64 + jn * 16 + q * 4) = make_uint2(pk2(O[jn][0] * inv, O[jn][1] * inv), pk2(O[jn][2] * inv, O[jn][3] * inv));
        }
    }
}


#define XB_TMO      128
#define XB_XCNT(j)  (256  + 64 * (j))
#define XB_XSUB(j)  (1280 + 64 * (j))
#define XB_XGEN(j)  (2304 + 64 * (j))
#define XB_TOP      3328
#define XB_TOPGEN   3392
#define XCD_BAR_WORDS 3456
#define XB_SPIN_CAP (1u << 22)
#define LAS __attribute__((address_space(3)))
__device__ __forceinline__ unsigned xb_ld(unsigned* p)              { return __hip_atomic_load(p, __ATOMIC_RELAXED, __HIP_MEMORY_SCOPE_AGENT); }
__device__ __forceinline__ unsigned xb_add(unsigned* p, unsigned v) { return __hip_atomic_fetch_add(p, v, __ATOMIC_RELAXED, __HIP_MEMORY_SCOPE_AGENT); }
__device__ __forceinline__ unsigned xb_xcc_id() { return (unsigned)__builtin_amdgcn_s_getreg((3 << 11) | 20) & 0xFu; }
#define XB_SPIN(cond, bar) do { unsigned _sp = 0; while (cond) { __builtin_amdgcn_s_sleep(1); \
    if ((++_sp & 255u) == 0u) { if (xb_ld(&(bar)[XB_TMO])) break; if (_sp > XB_SPIN_CAP) { atomicAdd(&(bar)[XB_TMO], 1u); break; } } } } while (0)
struct XcdBarrier { unsigned* bar; unsigned x; volatile LAS unsigned* st; };
__device__ __forceinline__ XcdBarrier xcd_barrier_post(unsigned* bar, volatile LAS unsigned* st) {
    XcdBarrier b; b.bar = bar; b.x = xb_xcc_id(); b.st = st;
    if (threadIdx.x == 0) (void)xb_add(&bar[XB_XCNT(b.x)], 1u);
    return b;
}
__device__ __forceinline__ void xcd_barrier_complete(unsigned* bar, unsigned x, unsigned& nloc, unsigned& nx) {
    const unsigned G = gridDim.x * gridDim.y * gridDim.z;
    unsigned sum, cnt, mine, sp = 0u;
    for (;;) {
        sum = 0u; cnt = 0u; mine = 0u;
#pragma unroll
        for (unsigned j = 0; j < 16; ++j) { const unsigned c = xb_ld(&bar[XB_XCNT(j)]); sum += c; cnt += (c > 0u) ? 1u : 0u; mine = (j == x) ? c : mine; }
        if (sum == G) break;
        __builtin_amdgcn_s_sleep(1);
        if ((++sp & 255u) == 0u) { if (xb_ld(&bar[XB_TMO])) break; if (sp > XB_SPIN_CAP) { atomicAdd(&bar[XB_TMO], 1u); break; } }
    }
    nloc = mine > 0u ? mine : 1u; nx = cnt > 0u ? cnt : 1u;
}
__device__ __forceinline__ void xcd_barrier(const XcdBarrier& b) {
    asm volatile("s_waitcnt vmcnt(0)" ::: "memory");
    __syncthreads();
    if (threadIdx.x == 0) {
        unsigned* bar = b.bar;
        __builtin_amdgcn_s_waitcnt(0);
        unsigned nloc = b.st[0], nx = b.st[1];
        if (nloc == 0u) { xcd_barrier_complete(bar, b.x, nloc, nx); b.st[0] = nloc; b.st[1] = nx; }
        const unsigned old = xb_add(&bar[XB_XSUB(b.x)], 1u);
        const unsigned gen = old / nloc;
        if (old + 1u == (gen + 1u) * nloc) {
            __builtin_amdgcn_fence(__ATOMIC_RELEASE, "agent");
            asm volatile("s_waitcnt vmcnt(0)" ::: "memory");
            const unsigned og = xb_add(&bar[XB_TOP], 1u);
            const unsigned tg = og / nx;
            if (og + 1u == (tg + 1u) * nx) xb_add(&bar[XB_TOPGEN], 1u);
            else XB_SPIN(xb_ld(&bar[XB_TOPGEN]) == tg, bar);
            __builtin_amdgcn_fence(__ATOMIC_ACQUIRE, "agent");
            xb_add(&bar[XB_XGEN(b.x)], 1u);
            asm volatile("s_waitcnt vmcnt(0)" ::: "memory");
        } else {
            XB_SPIN(xb_ld(&bar[XB_XGEN(b.x)]) == gen, bar);
            __builtin_amdgcn_fence(__ATOMIC_ACQUIRE, "agent");
            asm volatile("s_waitcnt vmcnt(0)" ::: "memory");
        }
    }
    __syncthreads();
}

#define PANEL_CNT_WORD 3584
__device__ __forceinline__ void panel_wait(unsigned* cnt) {
    asm volatile("s_waitcnt vmcnt(0)" ::: "memory");
    __syncthreads();
    if (threadIdx.x == 0) {
        __builtin_amdgcn_fence(__ATOMIC_RELEASE, "agent");
        asm volatile("s_waitcnt vmcnt(0)" ::: "memory");
        xb_add(cnt, 1u);
        unsigned sp = 0;
        while (xb_ld(cnt) < 8u) { __builtin_amdgcn_s_sleep(1); if (++sp > (1u << 24)) break; }
        __builtin_amdgcn_fence(__ATOMIC_ACQUIRE, "agent");
        asm volatile("s_waitcnt vmcnt(0)" ::: "memory");
    }
    __syncthreads();
}
#ifdef ONLY
#define EN(x) ((x) == ONLY)
#else
#define EN(x) true
#endif
constexpr int PPL = 13;
constexpr int N_PHASES = 1 + PPL * 2 + 1;
__device__ __forceinline__ void run_phase(P& p, int ph, unsigned char* smem, int rep) {
    int l = 0, s;
    if (ph == 0) s = 20; else if (ph == N_PHASES - 1) s = 21; else { l = (ph - 1) / PPL; s = (ph - 1) % PPL; }
    unsigned char* W = p.ws + WS_W; unsigned char* R = p.ws + WS_R;
    float* X = (float*)(p.ws + WS_X); const bf16* HN = (const bf16*)(p.ws + WS_HN); const float* MOD = (const float*)(p.ws + WS_MOD);
    PG8_LAS unsigned char* lds = (PG8_LAS unsigned char*)smem;
    bool do_norm = false, fin = false, has_res = false; int nl = l, nj = 0, resgi = 0, rbase = p.bid * NWV, rend = 8192, rstride = (int)gridDim.x * NWV; float coef = 0.5f;
    if (s == 20 || s == 0) {
        if (EN(12) && s == 20) ph_prologue(p, smem);
        if (s == 0 && l == 0) do_norm = true;
        if (EN(14) && (s == 20 || (s == 0 && l == 1))) { const int n = conv_count(l); for (int t = (s == 20) ? (int)((p.bid + gridDim.x - 32) % gridDim.x) : p.bid; t < n; t += gridDim.x) conv_weights_tile(p, smem, l, t); }
    } else if (s == 1 || s == 11) {
        if (EN(1)) {
            EpGU e{(bf16*)(R + R_ACT)}; pg8::StaticOrder S; S.init(8192, 5632, gridDim.x, p.bid);
            pg8::gemm_phase<EpGU, pg8::StaticOrder, true, true>(lds, pg8::Gemm{HN, (const bf16*)(W + (s == 1 ? W_GU0 : W_GU1)), 1024, 1024}, S, e, p.tid);
        }
    } else if (s == 2 || s == 9 || s == 12) {
        if (EN(2)) {
            EpPart e{(bf16*)(R + R_PART)};
            const bf16* A = (s == 9) ? HN : (const bf16*)(R + R_ACT);
            const bf16* Bt = (const bf16*)(W + (s == 9 ? W_OUT : (s == 2 ? W_D0 : W_D1)));
            const int ld = s == 9 ? 1024 : 2816;
            pg8::SplitK2Order S{p.bid, (int)gridDim.x, ld};
            pg8::gemm_phase<EpPart, pg8::SplitK2Order, true, true>(lds, pg8::Gemm{A, Bt, ld, ld / 2}, S, e, p.tid);
            const int pm = 4 * (p.bid & 7) + ((p.bid >> 3) & 3), sub = p.bid >> 5;
            panel_wait((unsigned*)(p.ws + WS_BAR) + PANEL_CNT_WORD + (l * 3 + (s == 2 ? 0 : (s == 9 ? 1 : 2))) * 32 + pm);
            do_norm = true; has_res = true; resgi = s == 2 ? 2 : (s == 9 ? 5 : 8); coef = s == 9 ? 1.0f : 0.5f;
            nj = s == 2 ? 1 : (s == 9 ? 2 : 0); nl = (s == 12) ? l + 1 : l; fin = (s == 12 && l == 1);
            rbase = pm * 256 + sub * 32; rend = rbase + 32; rstride = NWV;
        }
    } else if (s == 4) {
        if (l == 0) {
            if (EN(4)) {
                EpIn0 e{(bf16*)(R + R_PROJ), (float*)(R + R_GATES)}; pg8::StaticOrder S; S.init(8192, 3840, gridDim.x, p.bid);
                pg8::gemm_phase<EpIn0, pg8::StaticOrder, true, true>(lds, pg8::Gemm{HN, (const bf16*)(W + W_IN), 1024, 1024}, S, e, p.tid);
            }
        } else if (EN(15)) {
            EpIn1 e{(bf16*)(R + R_Q), (bf16*)(R + R_K), (bf16*)(R + R_VT), p.out + O_K, p.out + O_V}; pg8::StaticOrder S; S.init(8192, 3072, gridDim.x, p.bid);
            pg8::gemm_phase<EpIn1, pg8::StaticOrder, true, true>(lds, pg8::Gemm{HN, (const bf16*)(W + W_IN), 1024, 1024}, S, e, p.tid);
        }
    } else if (s == 5) {
        if (l == 0) {
            if (EN(5) && !(rep && PROBE == 9)) { { int t = p.tid; asm volatile("" : "+v"(t)); p.tid = t; } for (int t = (gridDim.x == 256 ? (p.bid & 7) * 32 + (p.bid >> 3) : p.bid); t < 1024; t += gridDim.x) mlstm_m1(p, smem, chunk_item_of(t)); }
            if (EN(16) && !(rep && PROBE == 8)) { { int t = p.tid; asm volatile("" : "+v"(t)); p.tid = t; } for (int t = (gridDim.x == 256 ? (p.bid & 7) * 32 + (p.bid >> 3) : p.bid); t < 1024; t += gridDim.x) delta_d1(p, smem, chunk_item_of(t)); }
        }
        else if (EN(17)) ph_attn(p, smem);
    } else if (s == 6) {
        if (l == 0) {
            const int nrest = (int)gridDim.x - 64;
            if (EN(18)) { if (nrest > 0) { if (p.bid >= 64) for (int t = p.bid - 64; t < 2592; t += nrest) mlstm_m2(p, t); } else { for (int t = p.bid; t < 2592; t += gridDim.x) mlstm_m2(p, t); } }
            if (EN(6)) {
                { int t = p.tid; asm volatile("" : "+v"(t)); p.tid = t; }
                if (nrest > 0) {
                    const int ri = p.bid - 64, t0 = p.bid < 64 ? p.bid : 64 + (nrest == 192 ? (ri & 7) * 24 + (ri >> 3) : ri);
                    for (int t = t0; t < 576; t += (p.bid < 64 ? 576 : nrest)) delta_d2(p, smem, t);
                }
                else { for (int t = p.bid; t < 576; t += gridDim.x) delta_d2(p, smem, t); }
            }
        }
    } else if (s == 7) {
        if (EN(19) && l == 0) { for (int t = (gridDim.x == 256 ? (p.bid & 7) * 32 + (p.bid >> 3) : p.bid); t < 1024; t += gridDim.x) mlstm_m3(p, smem, chunk_item_of(t)); }
    } else if (s == 8) {
        if (EN(7) && l == 0) ph_combine(p);
    }
    if (EN(0) && do_norm) ph_norm(p, fin ? 1 : nl, nj, has_res, l, resgi, coef, fin, rbase, rend, rstride, l == 0 && (s == 0 || s == 2));
}
__device__ __forceinline__ bool phase_empty(int ph) {
    if (ph == 0) return false;
    if (ph == N_PHASES - 1) return true;
    const int l = (ph - 1) / PPL, s = (ph - 1) % PPL;
    return s == 3 || s == 10 || (l == 1 && (s == 6 || s == 7 || s == 8));
}


__device__ __forceinline__ bool probe_match(int ph) {
#if PROBE == 0
    return false;
#else
    if (ph == 0) return PROBE == 5;
    if (ph == N_PHASES - 1) return PROBE == 6;
    const int l = (ph - 1) / PPL, s = (ph - 1) % PPL;
    if (PROBE == 1) return s == 1 || s == 4 || s == 11;
    if (PROBE == 11) return l == 1 && s == 0;
    if (PROBE == 12) return l == 0 && s == 8;
    if (PROBE == 2 || PROBE == 8 || PROBE == 9) return l == 0 && s == 5;
    if (PROBE == 3) return l == 0 && s == 6;
    if (PROBE == 4) return l == 1 && s == 5;
    if (PROBE == 6) return s == 0 || s == 3 || s == 10 || (l == 0 && s == 8);
    if (PROBE == 7) return ph == 1;
    if (PROBE == 10) return l == 0 && s == 7;
    return false;
#endif
}
__global__ void __launch_bounds__(NT) mega(P p) {
    extern __shared__ __attribute__((aligned(16))) unsigned char smem[];
    cg::grid_group grid = cg::this_grid();
    if (p.ph_hi > 100000) grid.sync();
    __shared__ uint4 xb_words;
    if (threadIdx.x == 0) xb_words = make_uint4(0u, 0u, 0u, 0u);
    __syncthreads();
    const XcdBarrier xb = xcd_barrier_post((unsigned*)(p.ws + WS_BAR), (volatile LAS unsigned*)&xb_words);
    const int wave_s = __builtin_amdgcn_readfirstlane((int)threadIdx.x >> 6);
    bool first = true;
    for (int ph = p.ph_lo; ph < p.ph_hi; ++ph) {
        if (phase_empty(ph)) continue;
        const int nrep = probe_match(ph) ? 2 : 1;
        for (int rep = 0; rep < nrep; ++rep) {
            if (!first) xcd_barrier(xb);
            first = false;
            { int t = (wave_s << 6) | (int)__builtin_amdgcn_mbcnt_hi(~0u, __builtin_amdgcn_mbcnt_lo(~0u, 0u)), b = (int)blockIdx.x; asm volatile("" : "+v"(t)); asm volatile("" : "+s"(b)); p.tid = t; p.bid = b; }
#if PROBE == 7
            if (rep) { for (int k = 0; k < 9; ++k) xcd_barrier(xb); continue; }
#endif
            run_phase(p, ph, smem, rep);
        }
    }
}

extern "C" void kernel_launch(void* const* d_in, const int* in_sizes, int n_in, void* d_out, int out_size, void* d_ws, size_t ws_size, hipStream_t stream) {
    static int grid_blocks = 0;
    if (!grid_blocks) {
        if (n_in != 29 || ws_size < WS_END) { fprintf(stderr, "kernel_launch: need 29 inputs and %zu B of workspace; got %d, %zu\n", (size_t)WS_END, n_in, ws_size); grid_blocks = -1; return; }
        int dev = 0, cus = 0, per_cu = 0;
        hipGetDevice(&dev);
        hipDeviceGetAttribute(&cus, hipDeviceAttributeMultiprocessorCount, dev);
        if (hipFuncSetAttribute((const void*)mega, hipFuncAttributeMaxDynamicSharedMemorySize, LDS_BYTES) != hipSuccess) { fprintf(stderr, "hipFuncSetAttribute failed\n"); grid_blocks = -1; return; }
        if (hipOccupancyMaxActiveBlocksPerMultiprocessor(&per_cu, (const void*)mega, NT, LDS_BYTES) != hipSuccess || per_cu < 1) { fprintf(stderr, "occupancy query failed (%d)\n", per_cu); per_cu = 1; (void)hipGetLastError(); }
        grid_blocks = cus * per_cu;
        if (grid_blocks < 256) { fprintf(stderr, "kernel_launch: needs 256 resident workgroups, have %d\n", grid_blocks); grid_blocks = -1; return; }
        grid_blocks = 256;
        fprintf(stderr, "kernel_launch: %d CUs x %d blocks\n", cus, per_cu);
    }
    if (grid_blocks < 0) return;
    if (hipMemsetAsync((char*)d_ws + WS_BAR, 0, 16384, stream) != hipSuccess) { fprintf(stderr, "memset failed\n"); return; }
    P p{};
    for (int i = 0; i < 29; ++i) p.in[i] = (const float*)d_in[i];
    p.out = (float*)d_out; p.ws = (unsigned char*)d_ws;
#if N_LAUNCH_MODE == 1
    p.ph_lo = 0; p.ph_hi = N_PHASES;
    void* args[] = {&p};
    hipError_t e = hipLaunchCooperativeKernel((const void*)mega, dim3(grid_blocks), dim3(NT), args, LDS_BYTES, stream);
    if (e != hipSuccess) fprintf(stderr, "cooperative launch failed: %s (grid %d)\n", hipGetErrorString(e), grid_blocks);
#else
    for (int ph = 0; ph < N_PHASES; ++ph) {
        if (ph > 0 && ph < N_PHASES - 1 && (ph - 1) / PPL == 1 && ((ph - 1) % PPL >= 6 && (ph - 1) % PPL <= 8)) continue;
        p.ph_lo = ph; p.ph_hi = ph + 1;
        hipLaunchKernelGGL(mega, dim3(grid_blocks), dim3(NT), LDS_BYTES, stream, p);
    }
#endif
}
```
